# Optimizing an MI355X kernel written in HIP

```python
import jax, jax.numpy as jnp
from jax import lax
import numpy as np

D_MODEL = 1024
BATCH = 8
SEQ = 2048
DEPTH = 1
DEC_BATCH = 128
DEC_SEQ = 1
PAST_LEN = 16384
PAGE_SIZE = 128

POOL_WIDTH = D_MODEL // 2
POOL_WINDOWS = (2, 4, 8, 16)
POOL_GROUPS = len(POOL_WINDOWS)
POOL_GROUP_DIM = POOL_WIDTH // POOL_GROUPS
POOL_OUT_GROUP_DIM = D_MODEL // POOL_GROUPS
POOL_BUF = max(POOL_WINDOWS) - 1
SSM_WIDTH = D_MODEL // 2
SSM_GROUP_DIM = 16
SSM_GROUPS = SSM_WIDTH // SSM_GROUP_DIM
SSM_STATE = 64
DT_MIN = 1e-3
DT_MAX = 1e-1
D_FF = 4 * D_MODEL
PLE_DIM = 256
EPS = 1e-6
IN_WIDTH = POOL_WIDTH + SSM_WIDTH + 2 * D_MODEL

kernel_name = 'pool_s5_gated_hybrid_step'


def rmsnorm(x, g):
    xf = x.astype(jnp.float32)
    y = xf * lax.rsqrt(jnp.mean(xf * xf, axis=-1, keepdims=True) + EPS)
    return (y * g.astype(jnp.float32)).astype(x.dtype)


def pool_mixer(u, buf, pos_start, w_pool, pool_scale):
    n, l, _ = u.shape
    lb = buf.shape[1]
    ext = jnp.concatenate([buf, u], axis=1).astype(jnp.float32)
    l_ext = ext.shape[1]
    pos = pos_start - lb + jnp.arange(l_ext, dtype=jnp.int32)
    groups = ext.reshape(n, l_ext, POOL_GROUPS, POOL_GROUP_DIM)
    outs = []
    for gi, w in enumerate(POOL_WINDOWS):
        xg = groups[:, :, gi]
        s = jnp.cumsum(xg, axis=1)
        s_lag = jnp.pad(s, ((0, 0), (w, 0), (0, 0)))[:, :l_ext]
        count = jnp.minimum(pos + 1, w).astype(jnp.float32)
        mean = (s - s_lag) / count[None, :, None]
        outs.append(mean - xg)
    pooled = jnp.stack(outs, axis=2)[:, lb:]
    y = jnp.einsum('nlgc,gcd->nlgd', pooled, w_pool.astype(jnp.float32))
    y = y.reshape(n, l, D_MODEL) * pool_scale.astype(jnp.float32)
    new_buf = ext[:, -POOL_BUF:].astype(buf.dtype)
    return y.astype(u.dtype), new_buf


def _cplx_affine_combine(e1, e2):
    a1r, a1i, b1r, b1i = e1
    a2r, a2i, b2r, b2i = e2
    ar = a2r * a1r - a2i * a1i
    ai = a2r * a1i + a2i * a1r
    br = a2r * b1r - a2i * b1i + b2r
    bi = a2r * b1i + a2i * b1r + b2i
    return (ar, ai, br, bi)


def s5_mixer(u, h0_re, h0_im, lam_re, lam_im, log_dt, b_re, b_im, c_re, c_im, d_skip):
    n, l, _ = u.shape
    uf = u.astype(jnp.float32).reshape(n, l, SSM_GROUPS, SSM_GROUP_DIM)
    dt = jnp.exp(log_dt.astype(jnp.float32))[:, None]
    lr = lam_re.astype(jnp.float32)
    li = lam_im.astype(jnp.float32)
    mag = jnp.exp(lr * dt)
    ang = li * dt
    abar_re = mag * jnp.cos(ang)
    abar_im = mag * jnp.sin(ang)
    den = lr * lr + li * li
    nr = abar_re - 1.0
    ni = abar_im
    k_re = ((nr * lr + ni * li) / den)[:, :, None]
    k_im = ((ni * lr - nr * li) / den)[:, :, None]
    br = b_re.astype(jnp.float32)
    bi = b_im.astype(jnp.float32)
    bbar_re = k_re * br - k_im * bi
    bbar_im = k_re * bi + k_im * br
    bu_re = jnp.einsum('nlgh,gph->nlgp', uf, bbar_re)
    bu_im = jnp.einsum('nlgh,gph->nlgp', uf, bbar_im)
    h0r = h0_re.astype(jnp.float32)
    h0i = h0_im.astype(jnp.float32)
    bu_re = bu_re.at[:, 0].add(abar_re * h0r - abar_im * h0i)
    bu_im = bu_im.at[:, 0].add(abar_re * h0i + abar_im * h0r)
    a_re = jnp.broadcast_to(abar_re, bu_re.shape)
    a_im = jnp.broadcast_to(abar_im, bu_im.shape)
    _, _, hr, hi = lax.associative_scan(_cplx_affine_combine, (a_re, a_im, bu_re, bu_im), axis=1)
    y = (jnp.einsum('nlgp,ghp->nlgh', hr, c_re.astype(jnp.float32))
         - jnp.einsum('nlgp,ghp->nlgh', hi, c_im.astype(jnp.float32))
         + d_skip.astype(jnp.float32).reshape(SSM_GROUPS, SSM_GROUP_DIM) * uf)
    return (y.reshape(n, l, SSM_WIDTH).astype(u.dtype),
            hr[:, -1].astype(h0_re.dtype), hi[:, -1].astype(h0_im.dtype))


def layer(x, p_l, pool_buf, h_re, h_im, pos_start,
          g_mix, w_in, w_pool, pool_scale, lam_re, lam_im, log_dt, b_re, b_im, c_re, c_im,
          d_skip, w_glu_v, w_glu_g, w_out, g_ff, w_ff1, w_ff2, g_ple, w_ple, w_ple_gate):
    h = rmsnorm(x, g_mix)
    z = h @ w_in
    s1 = POOL_WIDTH
    s2 = s1 + SSM_WIDTH
    s3 = s2 + D_MODEL
    u_a, u_b, gate_a, gate_b = z[..., :s1], z[..., s1:s2], z[..., s2:s3], z[..., s3:]
    branch_a, new_buf = pool_mixer(u_a, pool_buf, pos_start, w_pool, pool_scale)
    s, new_re, new_im = s5_mixer(u_b, h_re, h_im, lam_re, lam_im, log_dt, b_re, b_im,
                                 c_re, c_im, d_skip)
    gl = jax.nn.gelu(s)
    branch_b = (gl @ w_glu_v) * jax.nn.sigmoid(gl @ w_glu_g)
    merged = jax.nn.sigmoid(gate_a) * branch_a + jax.nn.sigmoid(gate_b) * branch_b
    x = x + merged @ w_out
    h2 = rmsnorm(x, g_ff)
    x = x + jnp.square(jax.nn.relu(h2 @ w_ff1)) @ w_ff2
    h3 = rmsnorm(x, g_ple)
    x = x + (p_l @ w_ple) * jax.nn.sigmoid(h3 @ w_ple_gate)
    return x, new_buf, new_re, new_im


def setup_inputs(seed: int = 0) -> dict:
    key = jax.random.key(seed)
    ks = jax.random.split(key, 32)
    f32 = jnp.float32
    nrm = lambda k, shape, s: jax.random.normal(k, shape, f32) * s
    gain = lambda k: 1.0 + 0.02 * jax.random.normal(k, (DEPTH, D_MODEL), f32)
    lam_im = (jnp.pi * jnp.arange(SSM_STATE, dtype=f32))[None, None, :] + nrm(ks[8], (DEPTH, SSM_GROUPS, SSM_STATE), 1e-3)
    return {
        'x_prompt': nrm(ks[0], (BATCH, SEQ, D_MODEL), 1.0),
        'x_sample': nrm(ks[1], (DEC_BATCH, DEC_SEQ, D_MODEL), 1.0),
        'p_prompt': nrm(ks[2], (DEPTH, BATCH, SEQ, PLE_DIM), 1.0),
        'p_sample': nrm(ks[3], (DEPTH, DEC_BATCH, DEC_SEQ, PLE_DIM), 1.0),
        'state_pool': nrm(ks[4], (DEPTH, DEC_BATCH, POOL_BUF, POOL_WIDTH), 1.0),
        'state_ssm_re': nrm(ks[5], (DEPTH, DEC_BATCH, SSM_GROUPS, SSM_STATE), 0.1),
        'state_ssm_im': nrm(ks[6], (DEPTH, DEC_BATCH, SSM_GROUPS, SSM_STATE), 0.1),
        'g_mix': gain(ks[7]),
        'w_in': nrm(ks[9], (DEPTH, D_MODEL, IN_WIDTH), D_MODEL ** -0.5),
        'w_pool': nrm(ks[10], (DEPTH, POOL_GROUPS, POOL_GROUP_DIM, POOL_OUT_GROUP_DIM), POOL_GROUP_DIM ** -0.5),
        'pool_scale': 1.0 + 0.1 * jax.random.normal(ks[11], (DEPTH, D_MODEL), f32),
        'lam_re': -0.5 + nrm(ks[12], (DEPTH, SSM_GROUPS, SSM_STATE), 1e-3),
        'lam_im': lam_im,
        'log_dt': jax.random.uniform(ks[13], (DEPTH, SSM_GROUPS), f32, float(np.log(DT_MIN)), float(np.log(DT_MAX))),
        'b_re': nrm(ks[14], (DEPTH, SSM_GROUPS, SSM_STATE, SSM_GROUP_DIM), (2 * SSM_GROUP_DIM) ** -0.5),
        'b_im': nrm(ks[15], (DEPTH, SSM_GROUPS, SSM_STATE, SSM_GROUP_DIM), (2 * SSM_GROUP_DIM) ** -0.5),
        'c_re': nrm(ks[16], (DEPTH, SSM_GROUPS, SSM_GROUP_DIM, SSM_STATE), SSM_STATE ** -0.5),
        'c_im': nrm(ks[17], (DEPTH, SSM_GROUPS, SSM_GROUP_DIM, SSM_STATE), SSM_STATE ** -0.5),
        'd_skip': nrm(ks[18], (DEPTH, SSM_WIDTH), 1.0),
        'w_glu_v': nrm(ks[19], (DEPTH, SSM_WIDTH, D_MODEL), SSM_WIDTH ** -0.5),
        'w_glu_g': nrm(ks[20], (DEPTH, SSM_WIDTH, D_MODEL), SSM_WIDTH ** -0.5),
        'w_out': nrm(ks[21], (DEPTH, D_MODEL, D_MODEL), D_MODEL ** -0.5),
        'g_ff': gain(ks[22]),
        'w_ff1': nrm(ks[23], (DEPTH, D_MODEL, D_FF), D_MODEL ** -0.5),
        'w_ff2': nrm(ks[24], (DEPTH, D_FF, D_MODEL), D_FF ** -0.5),
        'g_ple': gain(ks[25]),
        'w_ple': nrm(ks[26], (DEPTH, PLE_DIM, D_MODEL), PLE_DIM ** -0.5),
        'w_ple_gate': nrm(ks[27], (DEPTH, D_MODEL, D_MODEL), D_MODEL ** -0.5),
        'g_final': 1.0 + 0.02 * jax.random.normal(ks[28], (D_MODEL,), f32),
    }


def reference(x_prompt, x_sample, p_prompt, p_sample, state_pool, state_ssm_re, state_ssm_im,
              g_mix, w_in, w_pool, pool_scale, lam_re, lam_im, log_dt, b_re, b_im, c_re, c_im,
              d_skip, w_glu_v, w_glu_g, w_out, g_ff, w_ff1, w_ff2, g_ple, w_ple, w_ple_gate,
              g_final):
    yp = x_prompt
    ys = x_sample
    empty_buf = jnp.zeros((BATCH, 0, POOL_WIDTH), state_pool.dtype)
    zero_state = jnp.zeros((BATCH, SSM_GROUPS, SSM_STATE), state_ssm_re.dtype)
    pool_p, pool_s, re_p, im_p, re_s, im_s = [], [], [], [], [], []
    for l in range(DEPTH):
        lw = (g_mix[l], w_in[l], w_pool[l], pool_scale[l], lam_re[l], lam_im[l], log_dt[l],
              b_re[l], b_im[l], c_re[l], c_im[l], d_skip[l], w_glu_v[l], w_glu_g[l], w_out[l],
              g_ff[l], w_ff1[l], w_ff2[l], g_ple[l], w_ple[l], w_ple_gate[l])
        yp, bp, hrp, hip = layer(yp, p_prompt[l], empty_buf, zero_state, zero_state, 0, *lw)
        ys, bs, hrs, his = layer(ys, p_sample[l], state_pool[l], state_ssm_re[l],
                                 state_ssm_im[l], PAST_LEN, *lw)
        pool_p.append(bp)
        pool_s.append(bs)
        re_p.append(hrp)
        im_p.append(hip)
        re_s.append(hrs)
        im_s.append(his)
    y_prompt = rmsnorm(yp, g_final)
    y_sample = rmsnorm(ys, g_final)
    return (y_prompt, y_sample, jnp.stack(pool_p), jnp.stack(pool_s), jnp.stack(re_p),
            jnp.stack(im_p), jnp.stack(re_s), jnp.stack(im_s))
```

```cpp
#include <hip/hip_runtime.h>
#include <hip/hip_cooperative_groups.h>
#include <cstdio>
#include <cstdint>
namespace cg = cooperative_groups;

#ifndef ONE_LAUNCH
#define ONE_LAUNCH 1
#endif

#ifndef PROBE_P0
#define PROBE_P0 0
#endif
#ifndef PROBE_BAR
#define PROBE_BAR 0
#endif
#ifndef PROBE_P6
#define PROBE_P6 0
#endif
#ifndef PROBE_X
#define PROBE_X 0
#endif
#ifndef PROBE_P1
#define PROBE_P1 0
#endif
#ifndef REP_MIX
#define REP_MIX 1
#endif
#ifndef PHMASK
#define PHMASK 0x3ff
#endif
#define LAS __attribute__((address_space(3)))
typedef unsigned short bf16_t;
typedef short bf16x8 __attribute__((ext_vector_type(8)));
typedef float f32x4 __attribute__((ext_vector_type(4)));
typedef float f32x16 __attribute__((ext_vector_type(16)));
typedef unsigned u32x4 __attribute__((ext_vector_type(4)));
typedef unsigned u32x2 __attribute__((ext_vector_type(2)));

constexpr int D = 1024, NBATCH = 8, SEQ = 2048, MPR = NBATCH * SEQ, MS = 128, MV = MPR + MS, MP = 65 * 256;
constexpr int NZ = 3072, FF = 4096, PLE = 256, PW = 512;
constexpr float EPS = 1e-6f;
constexpr int NCHUNK = 16, CHUNK = 128;
constexpr size_t O_YP = 0, O_YS = 16777216, O_POOLP = 16908288, O_POOLS = 16969728, O_REP = 17952768, O_IMP = 17969152, O_RES = 17985536, O_IMS = 18247680;
constexpr size_t MiB = 1u << 20;
constexpr size_t WS_SS = 0;
constexpr size_t WS_BAR = 512 * 1024;
constexpr size_t BAR_BYTES = 16384;
constexpr size_t WS_ABAR = 1 * MiB;
constexpr size_t WS_A16 = WS_ABAR + 16384, WS_A128 = WS_A16 + 16384;
constexpr size_t WS_BBFR = WS_A128 + 16384;
constexpr size_t WS_BBFI = WS_BBFR + 131072;
constexpr size_t WS_BBT = WS_BBFI + 131072;
constexpr size_t WS_CT = WS_BBT + 131072;
constexpr size_t WS_EST = 2 * MiB;
constexpr size_t WS_WIN = 4 * MiB, WS_WGLU = 10 * MiB, WS_WOUT = 12 * MiB, WS_WFF1 = 14 * MiB, WS_WFF2 = 22 * MiB;
constexpr size_t WS_WPLE = 30 * MiB, WS_WPOOL = 30 * MiB + 512 * 1024, WS_WPLEG = 31 * MiB;
constexpr size_t WS_PB = 33 * MiB;
constexpr size_t WS_R1 = 42 * MiB;
constexpr size_t WS_R2 = 75 * MiB;
constexpr size_t WS_Z = 108 * MiB;
constexpr size_t WS_POOLED = WS_Z + (size_t)MP * NZ * 2;
constexpr size_t WS_GL = WS_POOLED + (size_t)MP * PW * 2;
constexpr size_t WS_F = WS_Z;
constexpr size_t WS_END = WS_GL + (size_t)MP * PW * 2;
constexpr size_t WS_SSP = 240 * MiB;
constexpr size_t SSP_STRIDE = (size_t)MP * 16;
static_assert(WS_END <= WS_SSP && WS_SSP + 3 * SSP_STRIDE * 4 <= 256 * MiB, "ws map");
static_assert(WS_F + (size_t)MP * FF * 2 <= WS_END, "F overlay");

constexpr int LDS_BYTES = 147456;

__device__ __forceinline__ unsigned f2bf(float f) { unsigned u = __builtin_bit_cast(unsigned, f); return (u + 0x7fffu + ((u >> 16) & 1u)) >> 16; }
typedef float f32x2_t __attribute__((ext_vector_type(2))); typedef __bf16 bf16x2_t __attribute__((ext_vector_type(2)));
__device__ __forceinline__ unsigned pk2(float lo, float hi) { f32x2_t v = {lo, hi}; bf16x2_t b = __builtin_convertvector(v, bf16x2_t); return __builtin_bit_cast(unsigned, b); }
__device__ __forceinline__ float bflo(unsigned w) { return __builtin_bit_cast(float, w << 16); }
__device__ __forceinline__ float bfhi(unsigned w) { return __builtin_bit_cast(float, w & 0xffff0000u); }
__device__ __forceinline__ float sigmoidf_(float x) { return __builtin_amdgcn_rcpf(1.0f + __expf(-x)); }
__device__ __forceinline__ float gelu_tanh(float x) { const float u = 1.5957691216f * (x + 0.044715f * x * x * x); return x * sigmoidf_(u); }
__device__ __forceinline__ float wave_sum(float v) {
#pragma unroll
    for (int o = 1; o < 64; o <<= 1) v += __shfl_xor(v, o);
    return v;
}
#define LDS_WAIT() asm volatile("s_waitcnt lgkmcnt(0)" ::: "memory")
#ifndef WT_STORES
#define WT_STORES 1
#endif
__device__ __forceinline__ void st8(void* p, u32x2 v) {
#if WT_STORES
    __hip_atomic_store((unsigned long long*)p, ((unsigned long long)v.y << 32) | (unsigned long long)v.x, __ATOMIC_RELAXED, __HIP_MEMORY_SCOPE_AGENT);
#else
    *(u32x2*)p = v;
#endif
}
__device__ __forceinline__ float ssp_rstd(const float* ssp, int row) {
    const f32x4* q = (const f32x4*)(ssp + (size_t)row * 16); const f32x4 a = q[0], b = q[1], c = q[2], d = q[3];
    const float t = ((a[0] + a[1]) + (a[2] + a[3])) + ((b[0] + b[1]) + (b[2] + b[3])) + ((c[0] + c[1]) + (c[2] + c[3])) + ((d[0] + d[1]) + (d[2] + d[3]));
    return rsqrtf(t * (1.f / 1024.f) + 1e-6f); }
__device__ __forceinline__ void ssp_put(float* ssp, int row, int slot, float p) { if (slot >= 0) ssp[(size_t)row * 16 + slot] = p; else atomicAdd(ssp + (size_t)row * 16, p); }

namespace pg8 {
constexpr int BM = 256, BK = 64, HALF = 128, HTB = HALF * BK * 2, STAGE_BYTES = 8 * HTB, NXCD = 8, WGM = 8;
__host__ __device__ __forceinline__ int lds_byte(int r, int c) { const int st = (r >> 4) * 2 + (c >> 5), rr = r & 15, cc = c & 31, ob = rr * 64 + cc * 2; return st * 1024 + (ob ^ (((ob >> 9) & 1) << 5)); }
__host__ __device__ __forceinline__ void stage_rc(int b, int& R, int& C) { const int st = b / 1024, sb = b % 1024, swz = sb ^ (((sb >> 9) & 1) << 5); R = (st >> 1) * 16 + swz / 64; C = (st & 1) * 32 + (swz % 64) / 2; }
struct Unit { int pm, pn; };
struct Gemm { const bf16_t* A; const bf16_t* Bt; int M, N, K, lda, ldb, a_pn_off; };
struct StaticOrder {
    int nM, nN, nwg, G, c;
    __host__ __device__ void init(int M, int N, int G_, int c_) { nM = M / BM; nN = N / BM; nwg = nM * nN; G = G_; c = c_; }
    __host__ __device__ bool next(int i, Unit& u) const {
        const long L = (long)i * G + c; if (L >= nwg) return false;
        int wgid = (int)L; { const int q = nwg / NXCD, r = nwg % NXCD, xcd = wgid % NXCD, off = wgid / NXCD; wgid = (xcd < r ? xcd * (q + 1) : r * (q + 1) + (xcd - r) * q) + off; }
        const int nig = WGM * nN, gid = wgid / nig, fm = gid * WGM, gsz = (nM - fm) < WGM ? (nM - fm) : WGM;
        u.pm = fm + ((wgid % nig) % gsz); u.pn = (wgid % nig) / gsz; return true;
    }
};

template <class F> struct EpiStrip {
    F f;
    __device__ __forceinline__ void operator()(const f32x4 (&acc)[2][2][4][2], const Unit& u, int wr, int wc, int fr, int fq) const {
#pragma unroll
        for (int ai = 0; ai < 2; ++ai)
#pragma unroll
            for (int m = 0; m < 4; ++m) {
                const int row = u.pm * BM + ai * HALF + wr * 64 + m * 16 + fr;
                const float rs = f.rowinit(row);
                float part = 0.f;
#pragma unroll
                for (int bj = 0; bj < 2; ++bj)
#pragma unroll
                    for (int n = 0; n < 2; ++n) {
                        const int col0 = u.pn * BM + bj * HALF + wc * 32 + n * 16 + 4 * fq;
                        part += f(row, col0, acc[ai][bj][m][n], rs);
                    }
                if (F::ROWSTAT) { part += __shfl_xor(part, 16); part += __shfl_xor(part, 32); if (fq == 0) f.rowdone(row, part, u.pn * 4 + wc); }
            }
    }
};

template <class Epi, bool ALIGN_EPI>
__device__ __forceinline__ void gemm_phase(LAS unsigned char* lds, const Gemm g, const StaticOrder& S, const Epi& E) {
    const int tid = threadIdx.x, wid = __builtin_amdgcn_readfirstlane(tid >> 6), lane = tid & 63, wr = wid >> 2, wc = wid & 3, fr = lane & 15, fq = lane >> 4;
    const int K = g.K; int nt = K / BK; asm volatile("" : "+s"(nt));
    unsigned voffA[2], voffB[2];
#pragma unroll
    for (int i = 0; i < 2; ++i) { int R, C; stage_rc(tid * 16 + i * 8192, R, C);
        voffA[i] = (unsigned)(R * g.lda + C) * 2u; voffB[i] = (unsigned)(R * g.ldb + C) * 2u; }
    const size_t kstep = (size_t)(BK * 2);
    const size_t hstepA = (size_t)HALF * g.lda * 2, hstepB = (size_t)HALF * g.ldb * 2;
    const size_t tstepA = 2 * hstepA, tstepB = 2 * hstepB;
    const unsigned ldsw = (unsigned)wid * 1024u;
    const int aoff = lds_byte(wr * 64 + fr, fq * 8), boff = lds_byte(wc * 32 + fr, fq * 8);
#define PG8_SA(b, h) (((b) * 2 + (h)) * HTB)
#define PG8_SB(b, h) ((4 + (b) * 2 + (h)) * HTB)
#define PG8_STAGE(bufoff, gbase, voff) do { _Pragma("unroll") for (int _i = 0; _i < 2; ++_i) \
        __builtin_amdgcn_global_load_lds((const unsigned*)((const char*)(gbase) + (voff)[_i]), (LAS unsigned*)(lds + (bufoff) + ldsw + _i * 8192), 16, 0, 0); } while (0)
#define PG8_LDA(dst, b, h) do { _Pragma("unroll") for (int m = 0; m < 4; ++m) _Pragma("unroll") for (int k = 0; k < 2; ++k) dst[m][k] = *(const LAS bf16x8*)(lds + PG8_SA(b, h) + aoff + m * 2048 + k * 1024); } while (0)
#define PG8_LDB(dst, b, h) do { _Pragma("unroll") for (int n = 0; n < 2; ++n) _Pragma("unroll") for (int k = 0; k < 2; ++k) dst[n][k] = *(const LAS bf16x8*)(lds + PG8_SB(b, h) + boff + n * 2048 + k * 1024); } while (0)
#define PG8_MMA(ai, bj, At, Bt) do { __builtin_amdgcn_s_setprio(1); _Pragma("unroll") for (int m = 0; m < 4; ++m) _Pragma("unroll") for (int n = 0; n < 2; ++n) _Pragma("unroll") for (int k = 0; k < 2; ++k) \
        acc[ai][bj][m][n] = __builtin_amdgcn_mfma_f32_16x16x32_bf16(Bt[n][k], At[m][k], acc[ai][bj][m][n], 0, 0, 0); __builtin_amdgcn_s_setprio(0); } while (0)
#define PG8_WAIT_V(n) asm volatile("s_waitcnt vmcnt(" #n ")" ::: "memory")
#define PG8_WAIT_L(n) asm volatile("s_waitcnt lgkmcnt(" #n ")" ::: "memory")
#define PG8_BAR __builtin_amdgcn_s_barrier()
#define PG8_SCHED __builtin_amdgcn_sched_barrier(0)
    Unit cur, nxt; int ui = 0;
    if (!S.next(0, cur)) return;
    f32x4 acc[2][2][4][2];
#pragma unroll
    for (int a = 0; a < 2; ++a)
#pragma unroll
        for (int b = 0; b < 2; ++b)
#pragma unroll
            for (int m = 0; m < 4; ++m)
#pragma unroll
                for (int n = 0; n < 2; ++n) acc[a][b][m][n] = (f32x4){0.f, 0.f, 0.f, 0.f};
    bf16x8 At[4][2], B0[2][2], B1[2][2];
    const char* cA = (const char*)g.A + (size_t)cur.pm * tstepA + (size_t)cur.pn * g.a_pn_off; const char* cB = (const char*)g.Bt + (size_t)cur.pn * tstepB;
    PG8_STAGE(PG8_SB(0, 0), cB, voffB); PG8_STAGE(PG8_SB(0, 1), cB + hstepB, voffB); PG8_STAGE(PG8_SA(0, 0), cA, voffA); PG8_STAGE(PG8_SA(0, 1), cA + hstepA, voffA);
    if (wr == 1) PG8_BAR;
    PG8_WAIT_V(2); PG8_BAR;
    PG8_STAGE(PG8_SB(1, 0), cB + kstep, voffB); PG8_STAGE(PG8_SA(1, 0), cA + kstep, voffA); PG8_STAGE(PG8_SB(1, 1), cB + hstepB + kstep, voffB);
    PG8_WAIT_V(6); PG8_BAR;
    for (;;) {
        const bool has_next = S.next(ui + 1, nxt);
        const char* nA = has_next ? (const char*)g.A + (size_t)nxt.pm * tstepA + (size_t)nxt.pn * g.a_pn_off : cA; const char* nB = has_next ? (const char*)g.Bt + (size_t)nxt.pn * tstepB : cB;
        for (int t = 0; t < nt; t += 2) {
            const bool last = (t == nt - 2);
            const char* a1 = cA + (size_t)(t + 1) * kstep;
            const char* a2 = last ? nA : cA + (size_t)(t + 2) * kstep; const char* b2 = last ? nB : cB + (size_t)(t + 2) * kstep;
            const char* a3 = a2 + kstep; const char* b3 = b2 + kstep;
            PG8_LDB(B0, 0, 0); PG8_LDB(B1, 0, 1); PG8_SCHED; PG8_LDA(At, 0, 0); PG8_STAGE(PG8_SA(1, 1), a1 + hstepA, voffA);
            PG8_WAIT_V(8); PG8_WAIT_L(0); PG8_BAR; PG8_MMA(0, 0, At, B0); PG8_MMA(0, 1, At, B1); PG8_BAR; PG8_SCHED;
            PG8_LDA(At, 0, 1); PG8_STAGE(PG8_SB(0, 0), b2, voffB); PG8_STAGE(PG8_SB(0, 1), b2 + hstepB, voffB); PG8_STAGE(PG8_SA(0, 0), a2, voffA);
            PG8_WAIT_V(8); PG8_WAIT_L(0); PG8_BAR; PG8_MMA(1, 0, At, B0); PG8_MMA(1, 1, At, B1); PG8_BAR; PG8_SCHED;
            PG8_LDB(B0, 1, 0); PG8_LDB(B1, 1, 1); PG8_SCHED; PG8_LDA(At, 1, 0); PG8_STAGE(PG8_SA(0, 1), a2 + hstepA, voffA);
            PG8_WAIT_V(8); PG8_WAIT_L(0); PG8_BAR; PG8_MMA(0, 0, At, B0); PG8_MMA(0, 1, At, B1); PG8_BAR; PG8_SCHED;
            PG8_LDA(At, 1, 1); PG8_STAGE(PG8_SB(1, 0), b3, voffB); PG8_STAGE(PG8_SB(1, 1), b3 + hstepB, voffB); PG8_STAGE(PG8_SA(1, 0), a3, voffA);
            PG8_WAIT_V(8); PG8_WAIT_L(0); PG8_BAR; PG8_MMA(1, 0, At, B0); PG8_MMA(1, 1, At, B1); PG8_BAR; PG8_SCHED;
        }
        if constexpr (ALIGN_EPI) { if (wr == 0) PG8_BAR; }
        E(acc, cur, wr, wc, fr, fq);
        if (!has_next) break;
#pragma unroll
        for (int a = 0; a < 2; ++a)
#pragma unroll
            for (int b = 0; b < 2; ++b)
#pragma unroll
                for (int m = 0; m < 4; ++m)
#pragma unroll
                    for (int n = 0; n < 2; ++n) acc[a][b][m][n] = (f32x4){0.f, 0.f, 0.f, 0.f};
        cur = nxt; cA = nA; cB = nB; ++ui;
        if constexpr (ALIGN_EPI) { if (wr == 1) PG8_BAR; }
    }
    PG8_WAIT_V(0);
    if constexpr (!ALIGN_EPI) { if (wr == 0) PG8_BAR; }
    PG8_BAR;
#undef PG8_SA
#undef PG8_SB
#undef PG8_STAGE
#undef PG8_LDA
#undef PG8_LDB
#undef PG8_MMA
#undef PG8_WAIT_V
#undef PG8_WAIT_L
#undef PG8_BAR
#undef PG8_SCHED
}
}

#define XB_TMO      128
#define XB_XCNT(j)  (256  + 64 * (j))
#define XB_XSUB(j)  (1280 + 64 * (j))
#define XB_XGEN(j)  (2304 + 64 * (j))
#define XB_TOP      3328
#define XB_TOPGEN   3392
#define XCD_BAR_WORDS 3456
#define XB_SPIN_CAP (1u << 18)
__device__ __forceinline__ unsigned xb_ld(unsigned* p)              { return __hip_atomic_load(p, __ATOMIC_RELAXED, __HIP_MEMORY_SCOPE_AGENT); }
__device__ __forceinline__ unsigned xb_add(unsigned* p, unsigned v) { return __hip_atomic_fetch_add(p, v, __ATOMIC_RELAXED, __HIP_MEMORY_SCOPE_AGENT); }
__device__ __forceinline__ unsigned xb_xcc_id() { return (unsigned)__builtin_amdgcn_s_getreg((3 << 11) | 20) & 0xFu; }
#define XB_SPIN(cond, bar) do { unsigned _sp = 0; while (cond) { __builtin_amdgcn_s_sleep(1); \
    if ((++_sp & 255u) == 0u) { if (xb_ld(&(bar)[XB_TMO])) break; if (_sp > XB_SPIN_CAP) { atomicAdd(&(bar)[XB_TMO], 1u); break; } } } } while (0)
struct XcdBarrier { unsigned* bar; unsigned x; volatile LAS unsigned* st; };
__device__ __forceinline__ XcdBarrier xcd_barrier_post(unsigned* bar, volatile LAS unsigned* st) {
    XcdBarrier b; b.bar = bar; b.x = xb_xcc_id(); b.st = st;
    if (threadIdx.x == 0) (void)xb_add(&bar[XB_XCNT(b.x)], 1u);
    return b;
}
__device__ __forceinline__ void xcd_barrier_complete(unsigned* bar, unsigned x, unsigned& nloc, unsigned& nx) {
    const unsigned G = gridDim.x * gridDim.y * gridDim.z;
    unsigned sum, cnt, mine, sp = 0u;
    for (;;) {
        sum = 0u; cnt = 0u; mine = 0u;
#pragma unroll
        for (unsigned j = 0; j < 16; ++j) { const unsigned c = xb_ld(&bar[XB_XCNT(j)]); sum += c; cnt += (c > 0u) ? 1u : 0u; mine = (j == x) ? c : mine; }
        if (sum == G) break;
        __builtin_amdgcn_s_sleep(1);
        if ((++sp & 255u) == 0u) { if (xb_ld(&bar[XB_TMO])) break; if (sp > XB_SPIN_CAP) { atomicAdd(&bar[XB_TMO], 1u); break; } }
    }
    nloc = mine > 0u ? mine : 1u; nx = cnt > 0u ? cnt : 1u;
}
__device__ __forceinline__ void xcd_barrier(const XcdBarrier& b) {
    asm volatile("s_waitcnt vmcnt(0)" ::: "memory");
    __syncthreads();
    if (threadIdx.x == 0) {
        unsigned* bar = b.bar;
        __builtin_amdgcn_s_waitcnt(0);
        unsigned nloc = b.st[0], nx = b.st[1];
        if (nloc == 0u) { xcd_barrier_complete(bar, b.x, nloc, nx); b.st[0] = nloc; b.st[1] = nx; }
        const unsigned old = xb_add(&bar[XB_XSUB(b.x)], 1u);
        const unsigned gen = old / nloc;
        if (old + 1u == (gen + 1u) * nloc) {
            __builtin_amdgcn_fence(__ATOMIC_RELEASE, "agent");
            asm volatile("s_waitcnt vmcnt(0)" ::: "memory");
            const unsigned og = xb_add(&bar[XB_TOP], 1u);
            const unsigned tg = og / nx;
            if (og + 1u == (tg + 1u) * nx) xb_add(&bar[XB_TOPGEN], 1u);
            else XB_SPIN(xb_ld(&bar[XB_TOPGEN]) == tg, bar);
            __builtin_amdgcn_fence(__ATOMIC_ACQUIRE, "agent");
            xb_add(&bar[XB_XGEN(b.x)], 1u);
            asm volatile("s_waitcnt vmcnt(0)" ::: "memory");
        } else {
            XB_SPIN(xb_ld(&bar[XB_XGEN(b.x)]) == gen, bar);
            __builtin_amdgcn_fence(__ATOMIC_ACQUIRE, "agent");
            asm volatile("s_waitcnt vmcnt(0)" ::: "memory");
        }
    }
    __syncthreads();
}

struct Args { const float* in[29]; float* out; unsigned char* ws; int ph_lo, ph_hi, coop, pad; };

struct Frame {
    LAS unsigned char* lds;
    int tid, lane, wave, G, gw, NGW;
    const float* const* in; float* out; unsigned char* ws;
};

struct FZ {
    static constexpr bool ROWSTAT = false;
    bf16_t* Z; const float* ss;
    __device__ __forceinline__ float rowinit(int row) const { return rsqrtf(ss[row] * (1.f / D) + EPS); }
    __device__ __forceinline__ float operator()(int row, int col, f32x4 v, float rs) const {
        u32x2 o; o.x = pk2(v[0] * rs, v[1] * rs); o.y = pk2(v[2] * rs, v[3] * rs);
        st8(Z + (size_t)row * NZ + col, o); return 0.f; }
    __device__ __forceinline__ void rowdone(int, float, int) const {}
};
struct FPool {
    static constexpr bool ROWSTAT = false;
    bf16_t* TMP; const bf16_t* Z; const float* pscale;
    __device__ __forceinline__ float rowinit(int) const { return 0.f; }
    __device__ __forceinline__ float operator()(int row, int col, f32x4 v, float) const {
        const u32x2 gz = *(const u32x2*)(Z + (size_t)row * NZ + 1024 + col);
        const f32x4 ps = *(const f32x4*)(pscale + col);
        u32x2 o; o.x = pk2(v[0] * ps[0] * sigmoidf_(bflo(gz.x)), v[1] * ps[1] * sigmoidf_(bfhi(gz.x)));
        o.y = pk2(v[2] * ps[2] * sigmoidf_(bflo(gz.y)), v[3] * ps[3] * sigmoidf_(bfhi(gz.y)));
        st8(TMP + (size_t)row * D + col, o); return 0.f; }
    __device__ __forceinline__ void rowdone(int, float, int) const {}
};
struct FGlu {
    static constexpr bool ROWSTAT = false;
    bf16_t* MG; const bf16_t* TMP; const bf16_t* Z;
    __device__ __forceinline__ float rowinit(int) const { return 0.f; }
    __device__ __forceinline__ float operator()(int row, int col, f32x4 v, float) const {
        const int j = col >> 1;
        const unsigned t = *(const unsigned*)(TMP + (size_t)row * D + j);
        const unsigned gb = *(const unsigned*)(Z + (size_t)row * NZ + 2048 + j);
        const float m0 = bflo(t) + sigmoidf_(bflo(gb)) * v[0] * sigmoidf_(v[1]);
        const float m1 = bfhi(t) + sigmoidf_(bfhi(gb)) * v[2] * sigmoidf_(v[3]);
        *(unsigned*)(MG + (size_t)row * D + j) = pk2(m0, m1); return 0.f; }
    __device__ __forceinline__ void rowdone(int, float, int) const {}
};
struct FOut {
    static constexpr bool ROWSTAT = true;
    const float* xp; const float* xs; bf16_t* XB; float* ss;
    __device__ __forceinline__ float rowinit(int) const { return 0.f; }
    __device__ __forceinline__ float operator()(int row, int col, f32x4 v, float) const {
        f32x4 x = (row < MPR) ? *(const f32x4*)(xp + (size_t)row * D + col) : *(const f32x4*)(xs + (size_t)(row - MPR) * D + col);
        x = x + v;
        u32x2 o; o.x = pk2(x[0], x[1]); o.y = pk2(x[2], x[3]); st8(XB + (size_t)row * D + col, o);
        return (x[0] * x[0] + x[1] * x[1]) + (x[2] * x[2] + x[3] * x[3]); }
    __device__ __forceinline__ void rowdone(int row, float p, int slot) const { ssp_put(ss, row, slot, p); }
};
struct FFf1 {
    static constexpr bool ROWSTAT = false;
    bf16_t* F; const float* ss;
    __device__ __forceinline__ float rowinit(int row) const { return ssp_rstd(ss, row); }
    __device__ __forceinline__ float operator()(int row, int col, f32x4 v, float rs) const {
        float a = fmaxf(v[0] * rs, 0.f), b = fmaxf(v[1] * rs, 0.f), c = fmaxf(v[2] * rs, 0.f), d = fmaxf(v[3] * rs, 0.f);
        u32x2 o; o.x = pk2(a * a, b * b); o.y = pk2(c * c, d * d);
        st8(F + (size_t)row * FF + col, o); return 0.f; }
    __device__ __forceinline__ void rowdone(int, float, int) const {}
};
struct FPle {
    static constexpr bool ROWSTAT = false;
    bf16_t* PL;
    __device__ __forceinline__ float rowinit(int) const { return 0.f; }
    __device__ __forceinline__ float operator()(int row, int col, f32x4 v, float) const {
        u32x2 o; o.x = pk2(v[0], v[1]); o.y = pk2(v[2], v[3]); st8(PL + (size_t)row * D + col, o); return 0.f; }
    __device__ __forceinline__ void rowdone(int, float, int) const {}
};
struct FFf2 {
    static constexpr bool ROWSTAT = true;
    bf16_t* XB; float* ss;
    __device__ __forceinline__ float rowinit(int) const { return 0.f; }
    __device__ __forceinline__ float operator()(int row, int col, f32x4 v, float) const {
        const u32x2 r = *(const u32x2*)(XB + (size_t)row * D + col);
        f32x4 x; x[0] = bflo(r.x) + v[0]; x[1] = bfhi(r.x) + v[1]; x[2] = bflo(r.y) + v[2]; x[3] = bfhi(r.y) + v[3];
        u32x2 o; o.x = pk2(x[0], x[1]); o.y = pk2(x[2], x[3]); st8(XB + (size_t)row * D + col, o);
        return (x[0] * x[0] + x[1] * x[1]) + (x[2] * x[2] + x[3] * x[3]); }
    __device__ __forceinline__ void rowdone(int row, float p, int slot) const { ssp_put(ss, row, slot, p); }
};
struct FPleg {
    static constexpr bool ROWSTAT = true;
    const bf16_t* XB; bf16_t* X3; const bf16_t* PL; const float* ss2; float* ss3;
    __device__ __forceinline__ float rowinit(int row) const { return ssp_rstd(ss2, row); }
    __device__ __forceinline__ float operator()(int row, int col, f32x4 v, float rs) const {
        const u32x2 r = *(const u32x2*)(XB + (size_t)row * D + col);
        const u32x2 pl = *(const u32x2*)(PL + (size_t)row * D + col);
        f32x4 x;
        x[0] = bflo(r.x) + bflo(pl.x) * sigmoidf_(v[0] * rs); x[1] = bfhi(r.x) + bfhi(pl.x) * sigmoidf_(v[1] * rs);
        x[2] = bflo(r.y) + bflo(pl.y) * sigmoidf_(v[2] * rs); x[3] = bfhi(r.y) + bfhi(pl.y) * sigmoidf_(v[3] * rs);
        u32x2 o; o.x = pk2(x[0], x[1]); o.y = pk2(x[2], x[3]); st8(X3 + (size_t)row * D + col, o);
        return (x[0] * x[0] + x[1] * x[1]) + (x[2] * x[2] + x[3] * x[3]); }
    __device__ __forceinline__ void rowdone(int row, float p, int slot) const { ssp_put(ss3, row, slot, p); }
};

template <class FN, int NT, int K, int N>
__device__ __forceinline__ void sgemm_phase(const Frame& Fr, const FN& f, const bf16_t* A, int lda, int a_grp_off, const bf16_t* Bt, int ldb) {
    const int lane = Fr.lane, fr = lane & 15, fq = lane >> 4, w = Fr.wave;
    constexpr int nslab = N / (16 * NT), nitems = 8 * nslab;
    constexpr int KPER = K >= 256 ? K / 8 : 32, KS = KPER / 32;
    constexpr int UBR = 36 / (1 + NT), UB0 = KS < 8 ? KS : 8, UB = UB0 < UBR ? UB0 : UBR;
    static_assert(KS % UB == 0, "sgemm unroll");
    LAS float* red = (LAS float*)Fr.lds;
    for (int it = blockIdx.x; it < nitems; it += Fr.G) {
        const int rt = it & 7, cs = it >> 3;
        const int col_base = cs * 16 * NT;
        const int akoff = (col_base >> 8) * a_grp_off;
        f32x4 acc[NT];
#pragma unroll
        for (int n = 0; n < NT; ++n) acc[n] = (f32x4){0.f, 0.f, 0.f, 0.f};
        const int k0 = w * KPER;
        if (k0 < K) {
            const bf16_t* ap = A + (size_t)(MPR + rt * 16 + fr) * lda + akoff + k0 + 8 * fq;
            const bf16_t* bp = Bt + (size_t)(col_base + fr) * ldb + k0 + 8 * fq;
#pragma unroll
            for (int kb = 0; kb < KS; kb += UB) {
                bf16x8 af[UB], bfr[UB][NT];
#pragma unroll
                for (int u = 0; u < UB; ++u) {
                    af[u] = *(const bf16x8*)(ap + (kb + u) * 32);
#pragma unroll
                    for (int n = 0; n < NT; ++n) bfr[u][n] = *(const bf16x8*)(bp + (size_t)n * 16 * ldb + (kb + u) * 32);
                }
#pragma unroll
                for (int u = 0; u < UB; ++u)
#pragma unroll
                    for (int n = 0; n < NT; ++n) acc[n] = __builtin_amdgcn_mfma_f32_16x16x32_bf16(bfr[u][n], af[u], acc[n], 0, 0, 0);
            }
        }
#pragma unroll
        for (int n = 0; n < NT; ++n) *(LAS f32x4*)(red + ((w * NT + n) * 64 + lane) * 4) = acc[n];
        __syncthreads();
        for (int n = w; n < NT; n += 8) {
            f32x4 sum = (f32x4){0.f, 0.f, 0.f, 0.f};
#pragma unroll
            for (int ww = 0; ww < 8; ++ww) sum = sum + *(const LAS f32x4*)(red + ((ww * NT + n) * 64 + lane) * 4);
            const int row = MPR + rt * 16 + fr, col0 = col_base + n * 16 + 4 * fq;
            const float rs = f.rowinit(row);
            float part = f(row, col0, sum, rs);
            if (FN::ROWSTAT) { part += __shfl_xor(part, 16); part += __shfl_xor(part, 32); if (fq == 0) f.rowdone(row, part, -1); }
        }
        __syncthreads();
    }
}

__device__ __forceinline__ void p0_transpose_item(const float* W, int K, int N, bf16_t* WT, int row_mul, int row_off, const float* gain, LAS float* scr, int item, int lane) {
    const int nblk = N / 32, kb = item / nblk, nb = item % nblk, k0 = 64 * kb, n0 = 32 * nb;
#pragma unroll
    for (int i = 0; i < 32; ++i) { const int kk = 2 * i + (lane >> 5); float w = W[(size_t)(k0 + kk) * N + n0 + (lane & 31)]; if (gain) w *= gain[k0 + kk]; scr[kk * 33 + (lane & 31)] = w; }
    LDS_WAIT();
    const int c = lane & 7;
#pragma unroll
    for (int j = 0; j < 4; ++j) { const int n = (lane >> 3) + 8 * j; const LAS float* s = scr + (8 * c) * 33 + n;
        u32x4 o; o.x = pk2(s[0 * 33], s[1 * 33]); o.y = pk2(s[2 * 33], s[3 * 33]); o.z = pk2(s[4 * 33], s[5 * 33]); o.w = pk2(s[6 * 33], s[7 * 33]);
        *(u32x4*)(WT + (size_t)(row_off + (n0 + n) * row_mul) * K + k0 + 8 * c) = o; }
    LDS_WAIT();
}

__device__ __forceinline__ void p0_prologue(const Frame& F) {
    LAS float* scr = (LAS float*)(F.lds + F.wave * 16384);
    unsigned char* ws = F.ws;
    constexpr int I_IN = 16 * 96, I_GV = 8 * 32, I_OUT = 16 * 32, I_F1 = 16 * 128, I_F2 = 64 * 32, I_PLE = 4 * 32, I_PG = 16 * 32, I_POOL = 2 * 8;
    constexpr int NITEMS = I_IN + 2 * I_GV + I_OUT + I_F1 + I_F2 + I_PLE + I_PG + 4 * I_POOL;
    for (int it = F.gw; it < NITEMS; it += F.NGW) {
        int r = it;
        if (r < I_IN) { p0_transpose_item(F.in[8], D, NZ, (bf16_t*)(ws + WS_WIN), 1, 0, F.in[7], scr, r, F.lane); continue; } r -= I_IN;
        if (r < I_GV) { p0_transpose_item(F.in[19], PW, D, (bf16_t*)(ws + WS_WGLU), 2, 0, nullptr, scr, r, F.lane); continue; } r -= I_GV;
        if (r < I_GV) { p0_transpose_item(F.in[20], PW, D, (bf16_t*)(ws + WS_WGLU), 2, 1, nullptr, scr, r, F.lane); continue; } r -= I_GV;
        if (r < I_OUT) { p0_transpose_item(F.in[21], D, D, (bf16_t*)(ws + WS_WOUT), 1, 0, nullptr, scr, r, F.lane); continue; } r -= I_OUT;
        if (r < I_F1) { p0_transpose_item(F.in[23], D, FF, (bf16_t*)(ws + WS_WFF1), 1, 0, F.in[22], scr, r, F.lane); continue; } r -= I_F1;
        if (r < I_F2) { p0_transpose_item(F.in[24], FF, D, (bf16_t*)(ws + WS_WFF2), 1, 0, nullptr, scr, r, F.lane); continue; } r -= I_F2;
        if (r < I_PLE) { p0_transpose_item(F.in[26], PLE, D, (bf16_t*)(ws + WS_WPLE), 1, 0, nullptr, scr, r, F.lane); continue; } r -= I_PLE;
        if (r < I_PG) { p0_transpose_item(F.in[27], D, D, (bf16_t*)(ws + WS_WPLEG), 1, 0, F.in[25], scr, r, F.lane); continue; } r -= I_PG;
        { const int g = r / I_POOL, rr = r % I_POOL; p0_transpose_item(F.in[9] + (size_t)g * 128 * 256, 128, 256, (bf16_t*)(ws + WS_WPOOL), 1, g * 256, nullptr, scr, rr, F.lane); }
    }
    float* ss0 = (float*)(ws + WS_SS);
    bf16_t* XB = (bf16_t*)(ws + WS_R1); bf16_t* PB = (bf16_t*)(ws + WS_PB);
    for (int m0 = F.gw; m0 < MV; m0 += 2 * F.NGW) {
        f32x4 v[2][4], pv[2];
#pragma unroll
        for (int q = 0; q < 2; ++q) {
            const int m = m0 + q * F.NGW;
            if (m < MV) {
                const float* xrow = (m < MPR) ? F.in[0] + (size_t)m * D : F.in[1] + (size_t)(m - MPR) * D;
                const f32x4* xr = (const f32x4*)xrow + F.lane;
#pragma unroll
                for (int j = 0; j < 4; ++j) v[q][j] = xr[64 * j];
                const float* prow = (m < MPR) ? F.in[2] + (size_t)m * PLE : F.in[3] + (size_t)(m - MPR) * PLE;
                pv[q] = ((const f32x4*)prow)[F.lane];
            }
        }
#pragma unroll
        for (int q = 0; q < 2; ++q) {
            const int m = m0 + q * F.NGW;
            if (m < MV) {
                float sq = 0.f;
#pragma unroll
                for (int j = 0; j < 4; ++j) sq += (v[q][j][0] * v[q][j][0] + v[q][j][1] * v[q][j][1]) + (v[q][j][2] * v[q][j][2] + v[q][j][3] * v[q][j][3]);
                sq = wave_sum(sq);
                if (F.lane == 0) ss0[m] = sq;
                u32x2* o8 = (u32x2*)(XB + (size_t)m * D) + F.lane;
#pragma unroll
                for (int j = 0; j < 4; ++j) { u32x2 o; o.x = pk2(v[q][j][0], v[q][j][1]); o.y = pk2(v[q][j][2], v[q][j][3]); o8[64 * j] = o; }
                u32x2 po; po.x = pk2(pv[q][0], pv[q][1]); po.y = pk2(pv[q][2], pv[q][3]);
                ((u32x2*)(PB + (size_t)m * PLE))[F.lane] = po;
            }
        }
    }
    const int gt = blockIdx.x * 512 + F.tid, NGT = F.G * 512;
    { float* ssp = (float*)(ws + WS_SSP); for (int i = gt; i < 3 * MS * 16; i += NGT) { const int a = i / (MS * 16), r = i % (MS * 16); ssp[a * SSP_STRIDE + (size_t)MPR * 16 + r] = 0.f; } }
    for (int i = MV + gt; i < MP; i += NGT) ss0[i] = 1.f;
    for (int i = gt; i < 2048; i += NGT) {
        const int g = i >> 6, p = i & 63;
        const double dt = exp((double)F.in[13][g]), lr = F.in[11][i], li = F.in[12][i];
        const double mag = exp(lr * dt), ang = li * dt, ar = mag * cos(ang), ai = mag * sin(ang);
        const double den = lr * lr + li * li, nr = ar - 1.0, ni = ai;
        const double kr = (nr * lr + ni * li) / den, ki = (ni * lr - nr * li) / den;
        ((float2*)(ws + WS_ABAR))[i] = make_float2((float)ar, (float)ai);
        double pr = ar, pi = ai;
#pragma unroll 1
        for (int s = 0; s < 7; ++s) { const double tr = pr * pr - pi * pi, ti = 2.0 * pr * pi; pr = tr; pi = ti;
            if (s == 3) ((float2*)(ws + WS_A16))[i] = make_float2((float)pr, (float)pi); }
        ((float2*)(ws + WS_A128))[i] = make_float2((float)pr, (float)pi);
        bf16_t* BBT = (bf16_t*)(ws + WS_BBT); bf16_t* CT = (bf16_t*)(ws + WS_CT);
        float* bbfr = (float*)(ws + WS_BBFR); float* bbfi = (float*)(ws + WS_BBFI);
        for (int h = 0; h < 16; ++h) {
            const double br = F.in[14][(size_t)i * 16 + h], bi = F.in[15][(size_t)i * 16 + h];
            const float bbr = (float)(kr * br - ki * bi), bbi = (float)(kr * bi + ki * br);
            bbfr[(size_t)i * 16 + h] = bbr; bbfi[(size_t)i * 16 + h] = bbi;
            BBT[((size_t)g * 128 + (p & 1) * 32 + (p >> 1)) * 16 + h] = (bf16_t)f2bf(bbr);
            BBT[((size_t)g * 128 + (2 + (p & 1)) * 32 + (p >> 1)) * 16 + h] = (bf16_t)f2bf(bbi);
            CT[((size_t)g * 16 + h) * 128 + 4 * (p >> 1) + (p & 1)] = (bf16_t)f2bf(F.in[16][((size_t)g * 16 + h) * 64 + p]);
            CT[((size_t)g * 16 + h) * 128 + 4 * (p >> 1) + 2 + (p & 1)] = (bf16_t)f2bf(-F.in[17][((size_t)g * 16 + h) * 64 + p]);
        }
    }
}

template <int W>
__device__ __forceinline__ void pool_item(const bf16_t* Z, bf16_t* POOLED, int row0, int t0, int grp, int lane) {
    float xa[15 + W], xb[15 + W];
    const int cofs = grp * 128 + 2 * lane;
#pragma unroll
    for (int i = 0; i < 15 + W; ++i) {
        const int dt = i - (W - 1);
        unsigned w = 0u;
        if (t0 + dt >= 0) w = *(const unsigned*)(Z + (size_t)(row0 + dt) * NZ + cofs);
        xa[i] = bflo(w); xb[i] = bfhi(w);
    }
#pragma unroll
    for (int o = 0; o < 16; ++o) {
        float sa = 0.f, sb = 0.f;
#pragma unroll
        for (int j = 0; j < W; ++j) { sa += xa[o + W - 1 - j]; sb += xb[o + W - 1 - j]; }
        const int t = t0 + o; const float inv = 1.0f / (float)((t + 1 < W) ? (t + 1) : W);
        const float ra = sa * inv - xa[o + W - 1], rb = sb * inv - xb[o + W - 1];
        *(unsigned*)(POOLED + (size_t)(row0 + o) * PW + cofs) = pk2(ra, rb);
    }
}

__device__ __forceinline__ float2 cmul(float2 a, float2 b) { return make_float2(a.x * b.x - a.y * b.y, a.x * b.y + a.y * b.x); }
__device__ __forceinline__ float2 cfma(float2 a, float2 h, float2 b) { return make_float2(a.x * h.x - a.y * h.y + b.x, a.x * h.y + a.y * h.x + b.y); }
__device__ __forceinline__ float2 shfl2(float2 v, int src) { return make_float2(__shfl(v.x, src), __shfl(v.y, src)); }

template <int PASS>
__device__ __forceinline__ void scan_item(const Frame& F, int item, LAS unsigned char* wlds) {
    unsigned char* ws = F.ws;
    const int lane = F.lane, n = lane & 31, hh = lane >> 5;
    const int g = item & 31, c = (item >> 5) & 15, b = item >> 9;
    const bf16_t* Z = (const bf16_t*)(ws + WS_Z);
    const bf16_t* BBT = (const bf16_t*)(ws + WS_BBT);
    const float2* ABAR = (const float2*)(ws + WS_ABAR); const float2* A16 = (const float2*)(ws + WS_A16); const float2* A128 = (const float2*)(ws + WS_A128);
    float2* EST = (float2*)(ws + WS_EST);
    const float2 a0 = ABAR[g * 64 + 2 * n], a1 = ABAR[g * 64 + 2 * n + 1];
    const float2 p0 = A16[g * 64 + 2 * n], p1 = A16[g * 64 + 2 * n + 1];
    bf16x8 bfrag[4];
#pragma unroll
    for (int q = 0; q < 4; ++q) bfrag[q] = *(const bf16x8*)(BBT + ((size_t)g * 128 + q * 32 + n) * 16 + 8 * hh);
    float2 H0 = make_float2(0.f, 0.f), H1 = make_float2(0.f, 0.f);
    if (PASS == 2) {
        const float2 q0 = A128[g * 64 + 2 * n], q1 = A128[g * 64 + 2 * n + 1];
        for (int cc = 0; cc < c; ++cc) {
            const float2* e = EST + (((size_t)b * NCHUNK + cc) * 32 + g) * 64 + 2 * n;
            H0 = cfma(q0, H0, e[0]); H1 = cfma(q1, H1, e[1]);
        }
    }
    const int tau = 16 * ((n >> 2) & 1) + 4 * (n >> 3) + (n & 3);
    const size_t rowbase = (size_t)b * SEQ + (size_t)c * CHUNK;
#pragma unroll 1
    for (int tt = 0; tt < 4; ++tt) {
        const size_t trow = rowbase + tt * 32;
        const bf16x8 afrag = *(const bf16x8*)(Z + (trow + tau) * NZ + 512 + g * 16 + 8 * hh);
        f32x16 acc[4];
#pragma unroll
        for (int q = 0; q < 4; ++q) {
#pragma unroll
            for (int r = 0; r < 16; ++r) acc[q][r] = 0.f;
            acc[q] = __builtin_amdgcn_mfma_f32_32x32x16_bf16(afrag, bfrag[q], acc[q], 0, 0, 0);
        }
        float2 e0 = make_float2(0.f, 0.f), e1 = make_float2(0.f, 0.f);
#pragma unroll
        for (int r = 0; r < 16; ++r) { e0 = cfma(a0, e0, make_float2(acc[0][r], acc[2][r])); e1 = cfma(a1, e1, make_float2(acc[1][r], acc[3][r])); }
        const float2 lo0 = shfl2(e0, n), lo1 = shfl2(e1, n), hi0 = shfl2(e0, n + 32), hi1 = shfl2(e1, n + 32);
        const float2 m0 = cfma(p0, H0, lo0), m1 = cfma(p1, H1, lo1);
        if (PASS == 2) {
            float2 k0 = hh ? m0 : H0, k1 = hh ? m1 : H1;
#pragma unroll
            for (int r = 0; r < 16; ++r) {
                k0 = cfma(a0, k0, make_float2(acc[0][r], acc[2][r])); k1 = cfma(a1, k1, make_float2(acc[1][r], acc[3][r]));
                u32x2 o; o.x = pk2(k0.x, k1.x); o.y = pk2(k0.y, k1.y);
                *(LAS u32x2*)(wlds + (16 * hh + r) * 272 + 8 * n) = o;
            }
        }
        H0 = cfma(p0, m0, hi0); H1 = cfma(p1, m1, hi1);
        if (PASS == 2) {
            LDS_WAIT();
            const bf16_t* CT = (const bf16_t*)(ws + WS_CT);
            const int fr = lane & 15, fq = lane >> 4;
            bf16x8 cf[4];
#pragma unroll
            for (int ks = 0; ks < 4; ++ks) cf[ks] = *(const bf16x8*)(CT + ((size_t)g * 16 + fr) * 128 + 32 * ks + 8 * fq);
            const f32x4 dsk = *(const f32x4*)(F.in[18] + g * 16 + 4 * fq);
            bf16_t* GL = (bf16_t*)(ws + WS_GL);
#pragma unroll
            for (int m = 0; m < 2; ++m) {
                f32x4 y = (f32x4){0.f, 0.f, 0.f, 0.f};
#pragma unroll
                for (int ks = 0; ks < 4; ++ks) {
                    const bf16x8 hf = *(const LAS bf16x8*)(wlds + (16 * m + fr) * 272 + 64 * ks + 16 * fq);
                    y = __builtin_amdgcn_mfma_f32_16x16x32_bf16(cf[ks], hf, y, 0, 0, 0);
                }
                const size_t row = trow + 16 * m + fr;
                const u32x2 uu = *(const u32x2*)(Z + row * NZ + 512 + g * 16 + 4 * fq);
                const float s0 = y[0] + dsk[0] * bflo(uu.x), s1 = y[1] + dsk[1] * bfhi(uu.x), s2 = y[2] + dsk[2] * bflo(uu.y), s3 = y[3] + dsk[3] * bfhi(uu.y);
                u32x2 o; o.x = pk2(gelu_tanh(s0), gelu_tanh(s1)); o.y = pk2(gelu_tanh(s2), gelu_tanh(s3));
                *(u32x2*)(GL + row * PW + g * 16 + 4 * fq) = o;
            }
            LDS_WAIT();
        }
    }
    if (PASS == 1) {
        if (hh == 0) { float2* e = EST + (((size_t)b * NCHUNK + c) * 32 + g) * 64 + 2 * n; e[0] = H0; e[1] = H1; }
    } else if (c == NCHUNK - 1) {
        if (hh == 0) {
            float* ore = F.out + O_REP + ((size_t)b * 32 + g) * 64 + 2 * n; float* oim = F.out + O_IMP + ((size_t)b * 32 + g) * 64 + 2 * n;
            ore[0] = H0.x; ore[1] = H1.x; oim[0] = H0.y; oim[1] = H1.y;
        }
    }
}

__device__ __forceinline__ void sample_mixer(const Frame& F) {
    unsigned char* ws = F.ws;
    const bf16_t* Z = (const bf16_t*)(ws + WS_Z);
    bf16_t* POOLED = (bf16_t*)(ws + WS_POOLED); bf16_t* GL = (bf16_t*)(ws + WS_GL);
    const int gt = blockIdx.x * 512 + F.tid, NGT = F.G * 512;
    for (int i = gt; i < MS * PW; i += NGT) {
        const int b = i >> 9, ch = i & 511, grp = ch >> 7, W = 2 << grp;
        const float* st = F.in[4] + (size_t)b * 15 * PW + ch;
        const float u = bflo((unsigned)Z[(size_t)(MPR + b) * NZ + ch]);
        float s = u;
        float* np = F.out + O_POOLS + (size_t)b * 15 * PW + ch;
#pragma unroll
        for (int r = 0; r < 15; ++r) { const float v = st[(size_t)r * PW]; if (r >= 16 - W) s += v; if (r >= 1) np[(size_t)(r - 1) * PW] = v; }
        np[(size_t)14 * PW] = u;
        POOLED[(size_t)(MPR + b) * PW + ch] = (bf16_t)f2bf(s / (float)W - u);
    }
    const float2* ABAR = (const float2*)(ws + WS_ABAR);
    const float* bbfr = (const float*)(ws + WS_BBFR); const float* bbfi = (const float*)(ws + WS_BBFI);
    for (int it = F.gw; it < MS * 32; it += F.NGW) {
        const int b = it >> 5, g = it & 31, p = F.lane;
        const bf16_t* ur = Z + (size_t)(MPR + b) * NZ + 512 + g * 16;
        float u[16];
#pragma unroll
        for (int h = 0; h < 16; ++h) u[h] = bflo((unsigned)ur[h]);
        float br = 0.f, bi = 0.f;
        const f32x4* brp = (const f32x4*)(bbfr + ((size_t)g * 64 + p) * 16); const f32x4* bip = (const f32x4*)(bbfi + ((size_t)g * 64 + p) * 16);
#pragma unroll
        for (int q = 0; q < 4; ++q) { const f32x4 x = brp[q], y = bip[q];
#pragma unroll
            for (int j = 0; j < 4; ++j) { br += x[j] * u[4 * q + j]; bi += y[j] * u[4 * q + j]; } }
        const float2 a = ABAR[g * 64 + p];
        const size_t si = ((size_t)b * 32 + g) * 64 + p;
        const float h0r = F.in[5][si], h0i = F.in[6][si];
        const float hr = a.x * h0r - a.y * h0i + br, hi = a.x * h0i + a.y * h0r + bi;
        F.out[O_RES + si] = hr; F.out[O_IMS + si] = hi;
        float yv = 0.f;
#pragma unroll
        for (int h = 0; h < 16; ++h) {
            const float cr = F.in[16][((size_t)g * 16 + h) * 64 + p], ci = F.in[17][((size_t)g * 16 + h) * 64 + p];
            const float t = wave_sum(cr * hr - ci * hi);
            if (F.lane == h) yv = t + F.in[18][g * 16 + h] * u[h];
        }
        if (F.lane < 16) GL[(size_t)(MPR + b) * PW + g * 16 + F.lane] = (bf16_t)f2bf(gelu_tanh(yv));
    }
}

__global__ void __launch_bounds__(512, 2) fwd_kernel(Args args) {
    extern __shared__ __attribute__((aligned(16))) unsigned char lds_raw[];
    Frame F;
    F.lds = (LAS unsigned char*)lds_raw;
    F.tid = threadIdx.x; F.lane = F.tid & 63; F.wave = __builtin_amdgcn_readfirstlane(F.tid >> 6);
    F.G = gridDim.x; F.gw = blockIdx.x * 8 + F.wave; F.NGW = F.G * 8;
    F.in = args.in; F.out = args.out; F.ws = args.ws;
    unsigned char* ws = args.ws;
    const int lo = args.ph_lo, hi = args.ph_hi;
    volatile LAS unsigned* bst = (volatile LAS unsigned*)(F.lds + 131072 + 1024);
    if (F.tid < 4) bst[F.tid] = 0u;
    __syncthreads();
    XcdBarrier bar; bar.bar = (unsigned*)(ws + WS_BAR); bar.x = 0; bar.st = bst;
    if (args.coop) bar = xcd_barrier_post((unsigned*)(ws + WS_BAR), bst);
    float* SS = (float*)(ws + WS_SS); float* SSP = (float*)(ws + WS_SSP);
    bf16_t* R1 = (bf16_t*)(ws + WS_R1); bf16_t* R2 = (bf16_t*)(ws + WS_R2); bf16_t* Zb = (bf16_t*)(ws + WS_Z);
    bf16_t* POOLED = (bf16_t*)(ws + WS_POOLED); bf16_t* GL = (bf16_t*)(ws + WS_GL); bf16_t* Fb = (bf16_t*)(ws + WS_F);
#define IN(k) (((PHMASK >> (k)) & 1) && lo <= (k) && (k) < hi)
#define SEAM(k) do { if (args.coop && IN(k) && IN((k) + 1)) { if (args.coop == 2) cg::this_grid().sync(); else { xcd_barrier(bar); if (PROBE_BAR) xcd_barrier(bar); } } } while (0)

    if (IN(0)) { p0_prologue(F);
#if PROBE_P0
        p0_prologue(F);
#endif
    }
    SEAM(0);
    if (IN(1)) {
        const bf16_t* W = (const bf16_t*)(ws + WS_WIN);
        pg8::Gemm g{R1, W, MPR, NZ, D, D, D, 0}; pg8::StaticOrder S; S.init(MPR, NZ, F.G, (int)blockIdx.x);
        pg8::EpiStrip<FZ> E{FZ{Zb, SS}};
        pg8::gemm_phase<pg8::EpiStrip<FZ>, true>(F.lds, g, S, E);
        __syncthreads();
        sgemm_phase<FZ, 6, D, NZ>(F, E.f, R1, D, 0, W, D);
#if PROBE_P1
        pg8::gemm_phase<pg8::EpiStrip<FZ>, true>(F.lds, g, S, E);
        __syncthreads();
        sgemm_phase<FZ, 6, D, NZ>(F, E.f, R1, D, 0, W, D);
#endif
    }
    SEAM(1);
    if (IN(2)) {
        for (int rep_ = 0; rep_ < REP_MIX; ++rep_) {
        for (int it = F.gw; it < 4096; it += F.NGW) {
            const int grp = it & 3, tb = it >> 2; const int row0 = tb * 16, t0 = row0 & (SEQ - 1);
            if (grp == 0) pool_item<2>(Zb, POOLED, row0, t0, 0, F.lane);
            else if (grp == 1) pool_item<4>(Zb, POOLED, row0, t0, 1, F.lane);
            else if (grp == 2) pool_item<8>(Zb, POOLED, row0, t0, 2, F.lane);
            else pool_item<16>(Zb, POOLED, row0, t0, 3, F.lane);
        }
        for (int it = F.gw; it < NBATCH * NCHUNK * 32; it += F.NGW) scan_item<1>(F, it, F.lds + F.wave * 16384);
        sample_mixer(F);
        }
        const int gt = blockIdx.x * 512 + F.tid, NGT = F.G * 512;
        for (int i = gt; i < NBATCH * 15 * PW; i += NGT) {
            const int b = i / (15 * PW), r = (i / PW) % 15, ch = i % PW;
            F.out[O_POOLP + i] = bflo((unsigned)Zb[((size_t)b * SEQ + SEQ - 15 + r) * NZ + ch]);
        }
    }
    SEAM(2);
    if (IN(3)) {
        const bf16_t* W = (const bf16_t*)(ws + WS_WPOOL);
        pg8::Gemm g{POOLED, W, MPR, D, 128, PW, 128, 256}; pg8::StaticOrder S; S.init(MPR, D, F.G, (int)blockIdx.x);
        pg8::EpiStrip<FPool> E{FPool{R1, Zb, F.in[10]}};
        pg8::gemm_phase<pg8::EpiStrip<FPool>, true>(F.lds, g, S, E);
#if PROBE_X
        __syncthreads(); pg8::gemm_phase<pg8::EpiStrip<FPool>, true>(F.lds, g, S, E);
#endif
        __syncthreads();
        sgemm_phase<FPool, 2, 128, D>(F, E.f, POOLED, PW, 128, W, 128);
        for (int rep_ = 0; rep_ < REP_MIX; ++rep_)
        for (int it = F.gw; it < NBATCH * NCHUNK * 32; it += F.NGW) scan_item<2>(F, it, F.lds + F.wave * 16384);
    }
    SEAM(3);
    if (IN(4)) {
        const bf16_t* W = (const bf16_t*)(ws + WS_WGLU);
        pg8::Gemm g{GL, W, MPR, 2 * D, PW, PW, PW, 0}; pg8::StaticOrder S; S.init(MPR, 2 * D, F.G, (int)blockIdx.x);
        pg8::EpiStrip<FGlu> E{FGlu{R2, R1, Zb}};
        pg8::gemm_phase<pg8::EpiStrip<FGlu>, true>(F.lds, g, S, E);
#if PROBE_X
        __syncthreads(); pg8::gemm_phase<pg8::EpiStrip<FGlu>, true>(F.lds, g, S, E);
#endif
        __syncthreads();
        sgemm_phase<FGlu, 4, PW, 2 * D>(F, E.f, GL, PW, 0, W, PW);
    }
    SEAM(4);
    if (IN(5)) {
        const bf16_t* W = (const bf16_t*)(ws + WS_WOUT);
        pg8::Gemm g{R2, W, MPR, D, D, D, D, 0}; pg8::StaticOrder S; S.init(MPR, D, F.G, (int)blockIdx.x);
        pg8::EpiStrip<FOut> E{FOut{F.in[0], F.in[1], R1, SSP}};
        pg8::gemm_phase<pg8::EpiStrip<FOut>, true>(F.lds, g, S, E);
        __syncthreads();
        sgemm_phase<FOut, 2, D, D>(F, E.f, R2, D, 0, W, D);
    }
    SEAM(5);
    if (IN(6)) {
        { const bf16_t* W = (const bf16_t*)(ws + WS_WFF1);
          pg8::Gemm g{R1, W, MPR, FF, D, D, D, 0}; pg8::StaticOrder S; S.init(MPR, FF, F.G, (int)blockIdx.x);
          pg8::EpiStrip<FFf1> E{FFf1{Fb, SSP}};
          pg8::gemm_phase<pg8::EpiStrip<FFf1>, true>(F.lds, g, S, E);
          __syncthreads();
          sgemm_phase<FFf1, 8, D, FF>(F, E.f, R1, D, 0, W, D); }
        { const bf16_t* W = (const bf16_t*)(ws + WS_WPLE); const bf16_t* PB = (const bf16_t*)(ws + WS_PB);
          pg8::Gemm g{PB, W, MPR, D, PLE, PLE, PLE, 0}; pg8::StaticOrder S; S.init(MPR, D, F.G, (int)blockIdx.x);
          pg8::EpiStrip<FPle> E{FPle{R2}};
          pg8::gemm_phase<pg8::EpiStrip<FPle>, true>(F.lds, g, S, E);
          __syncthreads();
          sgemm_phase<FPle, 2, PLE, D>(F, E.f, PB, PLE, 0, W, PLE); }
#if PROBE_P6
        { const bf16_t* W = (const bf16_t*)(ws + WS_WFF1);
          pg8::Gemm g{R1, W, MPR, FF, D, D, D, 0}; pg8::StaticOrder S; S.init(MPR, FF, F.G, (int)blockIdx.x);
          pg8::EpiStrip<FFf1> E{FFf1{Fb, SSP}};
          pg8::gemm_phase<pg8::EpiStrip<FFf1>, true>(F.lds, g, S, E);
          __syncthreads();
          sgemm_phase<FFf1, 8, D, FF>(F, E.f, R1, D, 0, W, D); }
        { const bf16_t* W = (const bf16_t*)(ws + WS_WPLE); const bf16_t* PB = (const bf16_t*)(ws + WS_PB);
          pg8::Gemm g{PB, W, MPR, D, PLE, PLE, PLE, 0}; pg8::StaticOrder S; S.init(MPR, D, F.G, (int)blockIdx.x);
          pg8::EpiStrip<FPle> E{FPle{R2}};
          pg8::gemm_phase<pg8::EpiStrip<FPle>, true>(F.lds, g, S, E);
          __syncthreads();
          sgemm_phase<FPle, 2, PLE, D>(F, E.f, PB, PLE, 0, W, PLE); }
#endif
    }
    SEAM(6);
    if (IN(7)) {
        const bf16_t* W = (const bf16_t*)(ws + WS_WFF2);
        pg8::Gemm g{Fb, W, MPR, D, FF, FF, FF, 0}; pg8::StaticOrder S; S.init(MPR, D, F.G, (int)blockIdx.x);
        pg8::EpiStrip<FFf2> E{FFf2{R1, SSP + SSP_STRIDE}};
        pg8::gemm_phase<pg8::EpiStrip<FFf2>, true>(F.lds, g, S, E);
        __syncthreads();
        sgemm_phase<FFf2, 2, FF, D>(F, E.f, Fb, FF, 0, W, FF);
    }
    SEAM(7);
    if (IN(8)) {
        const bf16_t* W = (const bf16_t*)(ws + WS_WPLEG);
        pg8::Gemm g{R1, W, MPR, D, D, D, D, 0}; pg8::StaticOrder S; S.init(MPR, D, F.G, (int)blockIdx.x);
        pg8::EpiStrip<FPleg> E{FPleg{R1, Zb, R2, SSP + SSP_STRIDE, SSP + 2 * SSP_STRIDE}};
        pg8::gemm_phase<pg8::EpiStrip<FPleg>, true>(F.lds, g, S, E);
        __syncthreads();
        sgemm_phase<FPleg, 2, D, D>(F, E.f, R1, D, 0, W, D);
    }
    SEAM(8);
    if (IN(9)) {
        const float* ss3 = SSP + 2 * SSP_STRIDE; const f32x4* gf = (const f32x4*)F.in[28];
        for (int m0 = F.gw; m0 < MV; m0 += 2 * F.NGW) {
            u32x4 v[2][2];
#pragma unroll
            for (int q = 0; q < 2; ++q) { const int m = m0 + q * F.NGW;
                if (m < MV) { const u32x4* xr = (const u32x4*)(Zb + (size_t)m * D) + F.lane; v[q][0] = xr[0]; v[q][1] = xr[64]; } }
#pragma unroll
            for (int q = 0; q < 2; ++q) { const int m = m0 + q * F.NGW;
                if (m < MV) { const float rs = ssp_rstd(ss3, m); f32x4* yr = (f32x4*)(F.out + (size_t)m * D);
#pragma unroll
                    for (int j = 0; j < 2; ++j) { const int c4 = (64 * j + F.lane) * 2;
                        const u32x4 w = v[q][j];
                        f32x4 a = (f32x4){bflo(w.x), bfhi(w.x), bflo(w.y), bfhi(w.y)}, b = (f32x4){bflo(w.z), bfhi(w.z), bflo(w.w), bfhi(w.w)};
                        a = a * rs; b = b * rs; a = a * gf[c4]; b = b * gf[c4 + 1]; yr[c4] = a; yr[c4 + 1] = b; } } }
        }
    }
#undef IN
#undef SEAM
}

extern "C" void kernel_launch(void* const* d_in, const int* in_sizes, int n_in, void* d_out, int out_size, void* d_ws, size_t ws_size, hipStream_t stream) {
    static int grid = 0;
    if (grid == 0) {
        int dev = 0, cus = 0, per_cu = 0;
        hipGetDevice(&dev);
        hipDeviceGetAttribute(&cus, hipDeviceAttributeMultiprocessorCount, dev);
        hipFuncSetAttribute((const void*)fwd_kernel, hipFuncAttributeMaxDynamicSharedMemorySize, LDS_BYTES);
        hipOccupancyMaxActiveBlocksPerMultiprocessor(&per_cu, (const void*)fwd_kernel, 512, LDS_BYTES);
        (void)hipGetLastError();
        if (per_cu < 1) per_cu = 1;
        grid = cus * 1;
        if (grid <= 0) grid = 256;
        if (ws_size < WS_END) { fprintf(stderr, "workspace too small: %zu < %zu\n", ws_size, (size_t)WS_END); }
    }
    Args a{};
    for (int i = 0; i < 29; ++i) a.in[i] = (const float*)d_in[i];
    a.out = (float*)d_out; a.ws = (unsigned char*)d_ws;
#if ONE_LAUNCH
    a.ph_lo = 0; a.ph_hi = 10; a.coop = 1;
    hipMemsetAsync((unsigned char*)d_ws + WS_BAR, 0, BAR_BYTES, stream);
    void* kargs[] = {&a};
    hipError_t e = hipLaunchCooperativeKernel((const void*)fwd_kernel, dim3(grid), dim3(512), kargs, LDS_BYTES, stream);
    if (e != hipSuccess) fprintf(stderr, "cooperative launch failed: %s (grid %d)\n", hipGetErrorString(e), grid);
#else
    for (int ph = 0; ph < 10; ++ph) {
        a.ph_lo = ph; a.ph_hi = ph + 1; a.coop = 0;
        hipLaunchKernelGGL(fwd_kernel, dim3(grid), dim3(512), LDS_BYTES, stream, a);
    }
#endif
}
```

```cpp
#include <hip/hip_runtime.h>
#include <hip/hip_cooperative_groups.h>
#include <cstdio>
#include <cstdint>
namespace cg = cooperative_groups;

#ifndef ONE_LAUNCH
#define ONE_LAUNCH 1
#endif

#ifndef PROBE_P0
#define PROBE_P0 0
#endif
#ifndef PROBE_BAR
#define PROBE_BAR 0
#endif
#ifndef PROBE_P6
#define PROBE_P6 0
#endif
#ifndef PROBE_X
#define PROBE_X 0
#endif
#ifndef PROBE_P1
#define PROBE_P1 0
#endif
#ifndef REP_MIX
#define REP_MIX 1
#endif
#ifndef PHMASK
#define PHMASK 0x3ff
#endif
#define LAS __attribute__((address_space(3)))
typedef unsigned short bf16_t;
typedef short bf16x8 __attribute__((ext_vector_type(8)));
typedef float f32x4 __attribute__((ext_vector_type(4)));
typedef float f32x16 __attribute__((ext_vector_type(16)));
typedef unsigned u32x4 __attribute__((ext_vector_type(4)));
typedef unsigned u32x2 __attribute__((ext_vector_type(2)));

constexpr int D = 1024, NBATCH = 8, SEQ = 2048, MPR = NBATCH * SEQ, MS = 128, MV = MPR + MS, MP = 65 * 256;
constexpr int NZ = 3072, FF = 4096, PLE = 256, PW = 512;
constexpr float EPS = 1e-6f;
constexpr int NCHUNK = 16, CHUNK = 128;
constexpr size_t O_YP = 0, O_YS = 16777216, O_POOLP = 16908288, O_POOLS = 16969728, O_REP = 17952768, O_IMP = 17969152, O_RES = 17985536, O_IMS = 18247680;
constexpr size_t MiB = 1u << 20;
constexpr size_t WS_SS = 0;
constexpr size_t WS_BAR = 512 * 1024;
constexpr size_t BAR_BYTES = 16384;
constexpr size_t WS_ABAR = 1 * MiB;
constexpr size_t WS_A16 = WS_ABAR + 16384, WS_A128 = WS_A16 + 16384;
constexpr size_t WS_BBFR = WS_A128 + 16384;
constexpr size_t WS_BBFI = WS_BBFR + 131072;
constexpr size_t WS_BBT = WS_BBFI + 131072;
constexpr size_t WS_CT = WS_BBT + 131072;
constexpr size_t WS_EST = 2 * MiB;
constexpr size_t WS_WIN = 4 * MiB, WS_WGLU = 10 * MiB, WS_WOUT = 12 * MiB, WS_WFF1 = 14 * MiB, WS_WFF2 = 22 * MiB;
constexpr size_t WS_WPLE = 30 * MiB, WS_WPOOL = 30 * MiB + 512 * 1024, WS_WPLEG = 31 * MiB;
constexpr size_t WS_PB = 33 * MiB;
constexpr size_t WS_R1 = 42 * MiB;
constexpr size_t WS_R2 = 75 * MiB;
constexpr size_t WS_Z = 108 * MiB;
constexpr size_t WS_POOLED = WS_Z + (size_t)MP * NZ * 2;
constexpr size_t WS_GL = WS_POOLED + (size_t)MP * PW * 2;
constexpr size_t WS_F = WS_Z;
constexpr size_t WS_END = WS_GL + (size_t)MP * PW * 2;
constexpr size_t WS_SSP = 240 * MiB;
constexpr size_t SSP_STRIDE = (size_t)MP * 16;
static_assert(WS_END <= WS_SSP && WS_SSP + 3 * SSP_STRIDE * 4 <= 256 * MiB, "ws map");
static_assert(WS_F + (size_t)MP * FF * 2 <= WS_END, "F overlay");

constexpr int LDS_BYTES = 147456;

__device__ __forceinline__ unsigned f2bf(float f) { unsigned u = __builtin_bit_cast(unsigned, f); return (u + 0x7fffu + ((u >> 16) & 1u)) >> 16; }
typedef float f32x2_t __attribute__((ext_vector_type(2))); typedef __bf16 bf16x2_t __attribute__((ext_vector_type(2)));
__device__ __forceinline__ unsigned pk2(float lo, float hi) { f32x2_t v = {lo, hi}; bf16x2_t b = __builtin_convertvector(v, bf16x2_t); return __builtin_bit_cast(unsigned, b); }
__device__ __forceinline__ float bflo(unsigned w) { return __builtin_bit_cast(float, w << 16); }
__device__ __forceinline__ float bfhi(unsigned w) { return __builtin_bit_cast(float, w & 0xffff0000u); }
__device__ __forceinline__ float sigmoidf_(float x) { return __builtin_amdgcn_rcpf(1.0f + __expf(-x)); }
__device__ __forceinline__ float gelu_tanh(float x) { const float u = 1.5957691216f * (x + 0.044715f * x * x * x); return x * sigmoidf_(u); }
__device__ __forceinline__ float wave_sum(float v) {
#pragma unroll
    for (int o = 1; o < 64; o <<= 1) v += __shfl_xor(v, o);
    return v;
}
#define LDS_WAIT() asm volatile("s_waitcnt lgkmcnt(0)" ::: "memory")
#ifndef WT_STORES
#define WT_STORES 0
#endif
__device__ __forceinline__ void st8(void* p, u32x2 v) {
#if WT_STORES
    __hip_atomic_store((unsigned long long*)p, ((unsigned long long)v.y << 32) | (unsigned long long)v.x, __ATOMIC_RELAXED, __HIP_MEMORY_SCOPE_AGENT);
#else
    *(u32x2*)p = v;
#endif
}
__device__ __forceinline__ float ssp_rstd(const float* ssp, int row) {
    const f32x4* q = (const f32x4*)(ssp + (size_t)row * 16); const f32x4 a = q[0], b = q[1], c = q[2], d = q[3];
    const float t = ((a[0] + a[1]) + (a[2] + a[3])) + ((b[0] + b[1]) + (b[2] + b[3])) + ((c[0] + c[1]) + (c[2] + c[3])) + ((d[0] + d[1]) + (d[2] + d[3]));
    return rsqrtf(t * (1.f / 1024.f) + 1e-6f); }
__device__ __forceinline__ void ssp_put(float* ssp, int row, int slot, float p) { if (slot >= 0) ssp[(size_t)row * 16 + slot] = p; else atomicAdd(ssp + (size_t)row * 16, p); }

namespace pg8 {
constexpr int BM = 256, BK = 64, HALF = 128, HTB = HALF * BK * 2, STAGE_BYTES = 8 * HTB, NXCD = 8, WGM = 8;
__host__ __device__ __forceinline__ int lds_byte(int r, int c) { const int st = (r >> 4) * 2 + (c >> 5), rr = r & 15, cc = c & 31, ob = rr * 64 + cc * 2; return st * 1024 + (ob ^ (((ob >> 9) & 1) << 5)); }
__host__ __device__ __forceinline__ void stage_rc(int b, int& R, int& C) { const int st = b / 1024, sb = b % 1024, swz = sb ^ (((sb >> 9) & 1) << 5); R = (st >> 1) * 16 + swz / 64; C = (st & 1) * 32 + (swz % 64) / 2; }
struct Unit { int pm, pn; };
struct Gemm { const bf16_t* A; const bf16_t* Bt; int M, N, K, lda, ldb, a_pn_off; };
struct StaticOrder {
    int nM, nN, nwg, G, c;
    __host__ __device__ void init(int M, int N, int G_, int c_) { nM = M / BM; nN = N / BM; nwg = nM * nN; G = G_; c = c_; }
    __host__ __device__ bool next(int i, Unit& u) const {
        const long L = (long)i * G + c; if (L >= nwg) return false;
        int wgid = (int)L; { const int q = nwg / NXCD, r = nwg % NXCD, xcd = wgid % NXCD, off = wgid / NXCD; wgid = (xcd < r ? xcd * (q + 1) : r * (q + 1) + (xcd - r) * q) + off; }
        const int nig = WGM * nN, gid = wgid / nig, fm = gid * WGM, gsz = (nM - fm) < WGM ? (nM - fm) : WGM;
        u.pm = fm + ((wgid % nig) % gsz); u.pn = (wgid % nig) / gsz; return true;
    }
};

template <class F> struct EpiStrip {
    F f;
    __device__ __forceinline__ void operator()(const f32x4 (&acc)[2][2][4][2], const Unit& u, int wr, int wc, int fr, int fq) const {
#pragma unroll
        for (int ai = 0; ai < 2; ++ai)
#pragma unroll
            for (int m = 0; m < 4; ++m) {
                const int row = u.pm * BM + ai * HALF + wr * 64 + m * 16 + fr;
                const float rs = f.rowinit(row);
                float part = 0.f;
#pragma unroll
                for (int bj = 0; bj < 2; ++bj)
#pragma unroll
                    for (int n = 0; n < 2; ++n) {
                        const int col0 = u.pn * BM + bj * HALF + wc * 32 + n * 16 + 4 * fq;
                        part += f(row, col0, acc[ai][bj][m][n], rs);
                    }
                if (F::ROWSTAT) { part += __shfl_xor(part, 16); part += __shfl_xor(part, 32); if (fq == 0) f.rowdone(row, part, u.pn * 4 + wc); }
            }
    }
};

template <class Epi, bool ALIGN_EPI>
__device__ __forceinline__ void gemm_phase(LAS unsigned char* lds, const Gemm g, const StaticOrder& S, const Epi& E) {
    const int tid = threadIdx.x, wid = __builtin_amdgcn_readfirstlane(tid >> 6), lane = tid & 63, wr = wid >> 2, wc = wid & 3, fr = lane & 15, fq = lane >> 4;
    const int K = g.K; int nt = K / BK; asm volatile("" : "+s"(nt));
    unsigned voffA[2], voffB[2];
#pragma unroll
    for (int i = 0; i < 2; ++i) { int R, C; stage_rc(tid * 16 + i * 8192, R, C);
        voffA[i] = (unsigned)(R * g.lda + C) * 2u; voffB[i] = (unsigned)(R * g.ldb + C) * 2u; }
    const size_t kstep = (size_t)(BK * 2);
    const size_t hstepA = (size_t)HALF * g.lda * 2, hstepB = (size_t)HALF * g.ldb * 2;
    const size_t tstepA = 2 * hstepA, tstepB = 2 * hstepB;
    const unsigned ldsw = (unsigned)wid * 1024u;
    const int aoff = lds_byte(wr * 64 + fr, fq * 8), boff = lds_byte(wc * 32 + fr, fq * 8);
#define PG8_SA(b, h) (((b) * 2 + (h)) * HTB)
#define PG8_SB(b, h) ((4 + (b) * 2 + (h)) * HTB)
#define PG8_STAGE(bufoff, gbase, voff) do { _Pragma("unroll") for (int _i = 0; _i < 2; ++_i) \
        __builtin_amdgcn_global_load_lds((const unsigned*)((const char*)(gbase) + (voff)[_i]), (LAS unsigned*)(lds + (bufoff) + ldsw + _i * 8192), 16, 0, 0); } while (0)
#define PG8_LDA(dst, b, h) do { _Pragma("unroll") for (int m = 0; m < 4; ++m) _Pragma("unroll") for (int k = 0; k < 2; ++k) dst[m][k] = *(const LAS bf16x8*)(lds + PG8_SA(b, h) + aoff + m * 2048 + k * 1024); } while (0)
#define PG8_LDB(dst, b, h) do { _Pragma("unroll") for (int n = 0; n < 2; ++n) _Pragma("unroll") for (int k = 0; k < 2; ++k) dst[n][k] = *(const LAS bf16x8*)(lds + PG8_SB(b, h) + boff + n * 2048 + k * 1024); } while (0)
#define PG8_MMA(ai, bj, At, Bt) do { __builtin_amdgcn_s_setprio(1); _Pragma("unroll") for (int m = 0; m < 4; ++m) _Pragma("unroll") for (int n = 0; n < 2; ++n) _Pragma("unroll") for (int k = 0; k < 2; ++k) \
        acc[ai][bj][m][n] = __builtin_amdgcn_mfma_f32_16x16x32_bf16(Bt[n][k], At[m][k], acc[ai][bj][m][n], 0, 0, 0); __builtin_amdgcn_s_setprio(0); } while (0)
#define PG8_WAIT_V(n) asm volatile("s_waitcnt vmcnt(" #n ")" ::: "memory")
#define PG8_WAIT_L(n) asm volatile("s_waitcnt lgkmcnt(" #n ")" ::: "memory")
#define PG8_BAR __builtin_amdgcn_s_barrier()
#define PG8_SCHED __builtin_amdgcn_sched_barrier(0)
    Unit cur, nxt; int ui = 0;
    if (!S.next(0, cur)) return;
    f32x4 acc[2][2][4][2];
#pragma unroll
    for (int a = 0; a < 2; ++a)
#pragma unroll
        for (int b = 0; b < 2; ++b)
#pragma unroll
            for (int m = 0; m < 4; ++m)
#pragma unroll
                for (int n = 0; n < 2; ++n) acc[a][b][m][n] = (f32x4){0.f, 0.f, 0.f, 0.f};
    bf16x8 At[4][2], B0[2][2], B1[2][2];
    const char* cA = (const char*)g.A + (size_t)cur.pm * tstepA + (size_t)cur.pn * g.a_pn_off; const char* cB = (const char*)g.Bt + (size_t)cur.pn * tstepB;
    PG8_STAGE(PG8_SB(0, 0), cB, voffB); PG8_STAGE(PG8_SB(0, 1), cB + hstepB, voffB); PG8_STAGE(PG8_SA(0, 0), cA, voffA); PG8_STAGE(PG8_SA(0, 1), cA + hstepA, voffA);
    if (wr == 1) PG8_BAR;
    PG8_WAIT_V(2); PG8_BAR;
    PG8_STAGE(PG8_SB(1, 0), cB + kstep, voffB); PG8_STAGE(PG8_SA(1, 0), cA + kstep, voffA); PG8_STAGE(PG8_SB(1, 1), cB + hstepB + kstep, voffB);
    PG8_WAIT_V(6); PG8_BAR;
    for (;;) {
        const bool has_next = S.next(ui + 1, nxt);
        const char* nA = has_next ? (const char*)g.A + (size_t)nxt.pm * tstepA + (size_t)nxt.pn * g.a_pn_off : cA; const char* nB = has_next ? (const char*)g.Bt + (size_t)nxt.pn * tstepB : cB;
        for (int t = 0; t < nt; t += 2) {
            const bool last = (t == nt - 2);
            const char* a1 = cA + (size_t)(t + 1) * kstep;
            const char* a2 = last ? nA : cA + (size_t)(t + 2) * kstep; const char* b2 = last ? nB : cB + (size_t)(t + 2) * kstep;
            const char* a3 = a2 + kstep; const char* b3 = b2 + kstep;
            PG8_LDB(B0, 0, 0); PG8_LDB(B1, 0, 1); PG8_SCHED; PG8_LDA(At, 0, 0); PG8_STAGE(PG8_SA(1, 1), a1 + hstepA, voffA);
            PG8_WAIT_V(8); PG8_WAIT_L(0); PG8_BAR; PG8_MMA(0, 0, At, B0); PG8_MMA(0, 1, At, B1); PG8_BAR; PG8_SCHED;
            PG8_LDA(At, 0, 1); PG8_STAGE(PG8_SB(0, 0), b2, voffB); PG8_STAGE(PG8_SB(0, 1), b2 + hstepB, voffB); PG8_STAGE(PG8_SA(0, 0), a2, voffA);
            PG8_WAIT_V(8); PG8_WAIT_L(0); PG8_BAR; PG8_MMA(1, 0, At, B0); PG8_MMA(1, 1, At, B1); PG8_BAR; PG8_SCHED;
            PG8_LDB(B0, 1, 0); PG8_LDB(B1, 1, 1); PG8_SCHED; PG8_LDA(At, 1, 0); PG8_STAGE(PG8_SA(0, 1), a2 + hstepA, voffA);
            PG8_WAIT_V(8); PG8_WAIT_L(0); PG8_BAR; PG8_MMA(0, 0, At, B0); PG8_MMA(0, 1, At, B1); PG8_BAR; PG8_SCHED;
            PG8_LDA(At, 1, 1); PG8_STAGE(PG8_SB(1, 0), b3, voffB); PG8_STAGE(PG8_SB(1, 1), b3 + hstepB, voffB); PG8_STAGE(PG8_SA(1, 0), a3, voffA);
            PG8_WAIT_V(8); PG8_WAIT_L(0); PG8_BAR; PG8_MMA(1, 0, At, B0); PG8_MMA(1, 1, At, B1); PG8_BAR; PG8_SCHED;
        }
        if constexpr (ALIGN_EPI) { if (wr == 0) PG8_BAR; }
        E(acc, cur, wr, wc, fr, fq);
        if (!has_next) break;
#pragma unroll
        for (int a = 0; a < 2; ++a)
#pragma unroll
            for (int b = 0; b < 2; ++b)
#pragma unroll
                for (int m = 0; m < 4; ++m)
#pragma unroll
                    for (int n = 0; n < 2; ++n) acc[a][b][m][n] = (f32x4){0.f, 0.f, 0.f, 0.f};
        cur = nxt; cA = nA; cB = nB; ++ui;
        if constexpr (ALIGN_EPI) { if (wr == 1) PG8_BAR; }
    }
    PG8_WAIT_V(0);
    if constexpr (!ALIGN_EPI) { if (wr == 0) PG8_BAR; }
    PG8_BAR;
#undef PG8_SA
#undef PG8_SB
#undef PG8_STAGE
#undef PG8_LDA
#undef PG8_LDB
#undef PG8_MMA
#undef PG8_WAIT_V
#undef PG8_WAIT_L
#undef PG8_BAR
#undef PG8_SCHED
}
}

#define XB_TMO      128
#define XB_XCNT(j)  (256  + 64 * (j))
#define XB_XSUB(j)  (1280 + 64 * (j))
#define XB_XGEN(j)  (2304 + 64 * (j))
#define XB_TOP      3328
#define XB_TOPGEN   3392
#define XCD_BAR_WORDS 3456
#define XB_SPIN_CAP (1u << 18)
__device__ __forceinline__ unsigned xb_ld(unsigned* p)              { return __hip_atomic_load(p, __ATOMIC_RELAXED, __HIP_MEMORY_SCOPE_AGENT); }
__device__ __forceinline__ unsigned xb_add(unsigned* p, unsigned v) { return __hip_atomic_fetch_add(p, v, __ATOMIC_RELAXED, __HIP_MEMORY_SCOPE_AGENT); }
__device__ __forceinline__ unsigned xb_xcc_id() { return (unsigned)__builtin_amdgcn_s_getreg((3 << 11) | 20) & 0xFu; }
#define XB_SPIN(cond, bar) do { unsigned _sp = 0; while (cond) { __builtin_amdgcn_s_sleep(1); \
    if ((++_sp & 255u) == 0u) { if (xb_ld(&(bar)[XB_TMO])) break; if (_sp > XB_SPIN_CAP) { atomicAdd(&(bar)[XB_TMO], 1u); break; } } } } while (0)
struct XcdBarrier { unsigned* bar; unsigned x; volatile LAS unsigned* st; };
__device__ __forceinline__ XcdBarrier xcd_barrier_post(unsigned* bar, volatile LAS unsigned* st) {
    XcdBarrier b; b.bar = bar; b.x = xb_xcc_id(); b.st = st;
    if (threadIdx.x == 0) (void)xb_add(&bar[XB_XCNT(b.x)], 1u);
    return b;
}
__device__ __forceinline__ void xcd_barrier_complete(unsigned* bar, unsigned x, unsigned& nloc, unsigned& nx) {
    const unsigned G = gridDim.x * gridDim.y * gridDim.z;
    unsigned sum, cnt, mine, sp = 0u;
    for (;;) {
        sum = 0u; cnt = 0u; mine = 0u;
#pragma unroll
        for (unsigned j = 0; j < 16; ++j) { const unsigned c = xb_ld(&bar[XB_XCNT(j)]); sum += c; cnt += (c > 0u) ? 1u : 0u; mine = (j == x) ? c : mine; }
        if (sum == G) break;
        __builtin_amdgcn_s_sleep(1);
        if ((++sp & 255u) == 0u) { if (xb_ld(&bar[XB_TMO])) break; if (sp > XB_SPIN_CAP) { atomicAdd(&bar[XB_TMO], 1u); break; } }
    }
    nloc = mine > 0u ? mine : 1u; nx = cnt > 0u ? cnt : 1u;
}
__device__ __forceinline__ void xcd_barrier(const XcdBarrier& b) {
    asm volatile("s_waitcnt vmcnt(0)" ::: "memory");
    __syncthreads();
    if (threadIdx.x == 0) {
        unsigned* bar = b.bar;
        __builtin_amdgcn_s_waitcnt(0);
        unsigned nloc = b.st[0], nx = b.st[1];
        if (nloc == 0u) { xcd_barrier_complete(bar, b.x, nloc, nx); b.st[0] = nloc; b.st[1] = nx; }
        const unsigned old = xb_add(&bar[XB_XSUB(b.x)], 1u);
        const unsigned gen = old / nloc;
        if (old + 1u == (gen + 1u) * nloc) {
            __builtin_amdgcn_fence(__ATOMIC_RELEASE, "agent");
            asm volatile("s_waitcnt vmcnt(0)" ::: "memory");
            const unsigned og = xb_add(&bar[XB_TOP], 1u);
            const unsigned tg = og / nx;
            if (og + 1u == (tg + 1u) * nx) xb_add(&bar[XB_TOPGEN], 1u);
            else XB_SPIN(xb_ld(&bar[XB_TOPGEN]) == tg, bar);
            __builtin_amdgcn_fence(__ATOMIC_ACQUIRE, "agent");
            xb_add(&bar[XB_XGEN(b.x)], 1u);
            asm volatile("s_waitcnt vmcnt(0)" ::: "memory");
        } else {
            XB_SPIN(xb_ld(&bar[XB_XGEN(b.x)]) == gen, bar);
            __builtin_amdgcn_fence(__ATOMIC_ACQUIRE, "agent");
            asm volatile("s_waitcnt vmcnt(0)" ::: "memory");
        }
    }
    __syncthreads();
}

struct Args { const float* in[29]; float* out; unsigned char* ws; int ph_lo, ph_hi, coop, pad; };

struct Frame {
    LAS unsigned char* lds;
    int tid, lane, wave, G, gw, NGW;
    const float* const* in; float* out; unsigned char* ws;
};

struct FZ {
    static constexpr bool ROWSTAT = false;
    bf16_t* Z; const float* ss;
    __device__ __forceinline__ float rowinit(int row) const { return rsqrtf(ss[row] * (1.f / D) + EPS); }
    __device__ __forceinline__ float operator()(int row, int col, f32x4 v, float rs) const {
        u32x2 o; o.x = pk2(v[0] * rs, v[1] * rs); o.y = pk2(v[2] * rs, v[3] * rs);
        st8(Z + (size_t)row * NZ + col, o); return 0.f; }
    __device__ __forceinline__ void rowdone(int, float, int) const {}
};
struct FPool {
    static constexpr bool ROWSTAT = false;
    bf16_t* TMP; const bf16_t* Z; const float* pscale;
    __device__ __forceinline__ float rowinit(int) const { return 0.f; }
    __device__ __forceinline__ float operator()(int row, int col, f32x4 v, float) const {
        const u32x2 gz = *(const u32x2*)(Z + (size_t)row * NZ + 1024 + col);
        const f32x4 ps = *(const f32x4*)(pscale + col);
        u32x2 o; o.x = pk2(v[0] * ps[0] * sigmoidf_(bflo(gz.x)), v[1] * ps[1] * sigmoidf_(bfhi(gz.x)));
        o.y = pk2(v[2] * ps[2] * sigmoidf_(bflo(gz.y)), v[3] * ps[3] * sigmoidf_(bfhi(gz.y)));
        st8(TMP + (size_t)row * D + col, o); return 0.f; }
    __device__ __forceinline__ void rowdone(int, float, int) const {}
};
struct FGlu {
    static constexpr bool ROWSTAT = false;
    bf16_t* MG; const bf16_t* TMP; const bf16_t* Z;
    __device__ __forceinline__ float rowinit(int) const { return 0.f; }
    __device__ __forceinline__ float operator()(int row, int col, f32x4 v, float) const {
        const int j = col >> 1;
        const unsigned t = *(const unsigned*)(TMP + (size_t)row * D + j);
        const unsigned gb = *(const unsigned*)(Z + (size_t)row * NZ + 2048 + j);
        const float m0 = bflo(t) + sigmoidf_(bflo(gb)) * v[0] * sigmoidf_(v[1]);
        const float m1 = bfhi(t) + sigmoidf_(bfhi(gb)) * v[2] * sigmoidf_(v[3]);
        *(unsigned*)(MG + (size_t)row * D + j) = pk2(m0, m1); return 0.f; }
    __device__ __forceinline__ void rowdone(int, float, int) const {}
};
struct FOut {
    static constexpr bool ROWSTAT = true;
    const float* xp; const float* xs; bf16_t* XB; float* ss;
    __device__ __forceinline__ float rowinit(int) const { return 0.f; }
    __device__ __forceinline__ float operator()(int row, int col, f32x4 v, float) const {
        f32x4 x = (row < MPR) ? *(const f32x4*)(xp + (size_t)row * D + col) : *(const f32x4*)(xs + (size_t)(row - MPR) * D + col);
        x = x + v;
        u32x2 o; o.x = pk2(x[0], x[1]); o.y = pk2(x[2], x[3]); st8(XB + (size_t)row * D + col, o);
        return (x[0] * x[0] + x[1] * x[1]) + (x[2] * x[2] + x[3] * x[3]); }
    __device__ __forceinline__ void rowdone(int row, float p, int slot) const { ssp_put(ss, row, slot, p); }
};
struct FFf1 {
    static constexpr bool ROWSTAT = false;
    bf16_t* F; const float* ss;
    __device__ __forceinline__ float rowinit(int row) const { return ssp_rstd(ss, row); }
    __device__ __forceinline__ float operator()(int row, int col, f32x4 v, float rs) const {
        float a = fmaxf(v[0] * rs, 0.f), b = fmaxf(v[1] * rs, 0.f), c = fmaxf(v[2] * rs, 0.f), d = fmaxf(v[3] * rs, 0.f);
        u32x2 o; o.x = pk2(a * a, b * b); o.y = pk2(c * c, d * d);
        st8(F + (size_t)row * FF + col, o); return 0.f; }
    __device__ __forceinline__ void rowdone(int, float, int) const {}
};
struct FPle {
    static constexpr bool ROWSTAT = false;
    bf16_t* PL;
    __device__ __forceinline__ float rowinit(int) const { return 0.f; }
    __device__ __forceinline__ float operator()(int row, int col, f32x4 v, float) const {
        u32x2 o; o.x = pk2(v[0], v[1]); o.y = pk2(v[2], v[3]); st8(PL + (size_t)row * D + col, o); return 0.f; }
    __device__ __forceinline__ void rowdone(int, float, int) const {}
};
struct FFf2 {
    static constexpr bool ROWSTAT = true;
    bf16_t* XB; float* ss;
    __device__ __forceinline__ float rowinit(int) const { return 0.f; }
    __device__ __forceinline__ float operator()(int row, int col, f32x4 v, float) const {
        const u32x2 r = *(const u32x2*)(XB + (size_t)row * D + col);
        f32x4 x; x[0] = bflo(r.x) + v[0]; x[1] = bfhi(r.x) + v[1]; x[2] = bflo(r.y) + v[2]; x[3] = bfhi(r.y) + v[3];
        u32x2 o; o.x = pk2(x[0], x[1]); o.y = pk2(x[2], x[3]); st8(XB + (size_t)row * D + col, o);
        return (x[0] * x[0] + x[1] * x[1]) + (x[2] * x[2] + x[3] * x[3]); }
    __device__ __forceinline__ void rowdone(int row, float p, int slot) const { ssp_put(ss, row, slot, p); }
};
struct FPleg {
    static constexpr bool ROWSTAT = true;
    const bf16_t* XB; bf16_t* X3; const bf16_t* PL; const float* ss2; float* ss3;
    __device__ __forceinline__ float rowinit(int row) const { return ssp_rstd(ss2, row); }
    __device__ __forceinline__ float operator()(int row, int col, f32x4 v, float rs) const {
        const u32x2 r = *(const u32x2*)(XB + (size_t)row * D + col);
        const u32x2 pl = *(const u32x2*)(PL + (size_t)row * D + col);
        f32x4 x;
        x[0] = bflo(r.x) + bflo(pl.x) * sigmoidf_(v[0] * rs); x[1] = bfhi(r.x) + bfhi(pl.x) * sigmoidf_(v[1] * rs);
        x[2] = bflo(r.y) + bflo(pl.y) * sigmoidf_(v[2] * rs); x[3] = bfhi(r.y) + bfhi(pl.y) * sigmoidf_(v[3] * rs);
        u32x2 o; o.x = pk2(x[0], x[1]); o.y = pk2(x[2], x[3]); st8(X3 + (size_t)row * D + col, o);
        return (x[0] * x[0] + x[1] * x[1]) + (x[2] * x[2] + x[3] * x[3]); }
    __device__ __forceinline__ void rowdone(int row, float p, int slot) const { ssp_put(ss3, row, slot, p); }
};

template <class FN, int NT, int K, int N>
__device__ __forceinline__ void sgemm_phase(const Frame& Fr, const FN& f, const bf16_t* A, int lda, int a_grp_off, const bf16_t* Bt, int ldb) {
    const int lane = Fr.lane, fr = lane & 15, fq = lane >> 4, w = Fr.wave;
    constexpr int nslab = N / (16 * NT), nitems = 8 * nslab;
    constexpr int KPER = K >= 256 ? K / 8 : 32, KS = KPER / 32;
    constexpr int UBR = 36 / (1 + NT), UB0 = KS < 8 ? KS : 8, UB = UB0 < UBR ? UB0 : UBR;
    static_assert(KS % UB == 0, "sgemm unroll");
    LAS float* red = (LAS float*)Fr.lds;
    for (int it = blockIdx.x; it < nitems; it += Fr.G) {
        const int rt = it & 7, cs = it >> 3;
        const int col_base = cs * 16 * NT;
        const int akoff = (col_base >> 8) * a_grp_off;
        f32x4 acc[NT];
#pragma unroll
        for (int n = 0; n < NT; ++n) acc[n] = (f32x4){0.f, 0.f, 0.f, 0.f};
        const int k0 = w * KPER;
        if (k0 < K) {
            const bf16_t* ap = A + (size_t)(MPR + rt * 16 + fr) * lda + akoff + k0 + 8 * fq;
            const bf16_t* bp = Bt + (size_t)(col_base + fr) * ldb + k0 + 8 * fq;
#pragma unroll
            for (int kb = 0; kb < KS; kb += UB) {
                bf16x8 af[UB], bfr[UB][NT];
#pragma unroll
                for (int u = 0; u < UB; ++u) {
                    af[u] = *(const bf16x8*)(ap + (kb + u) * 32);
#pragma unroll
                    for (int n = 0; n < NT; ++n) bfr[u][n] = *(const bf16x8*)(bp + (size_t)n * 16 * ldb + (kb + u) * 32);
                }
#pragma unroll
                for (int u = 0; u < UB; ++u)
#pragma unroll
                    for (int n = 0; n < NT; ++n) acc[n] = __builtin_amdgcn_mfma_f32_16x16x32_bf16(bfr[u][n], af[u], acc[n], 0, 0, 0);
            }
        }
#pragma unroll
        for (int n = 0; n < NT; ++n) *(LAS f32x4*)(red + ((w * NT + n) * 64 + lane) * 4) = acc[n];
        __syncthreads();
        for (int n = w; n < NT; n += 8) {
            f32x4 sum = (f32x4){0.f, 0.f, 0.f, 0.f};
#pragma unroll
            for (int ww = 0; ww < 8; ++ww) sum = sum + *(const LAS f32x4*)(red + ((ww * NT + n) * 64 + lane) * 4);
            const int row = MPR + rt * 16 + fr, col0 = col_base + n * 16 + 4 * fq;
            const float rs = f.rowinit(row);
            float part = f(row, col0, sum, rs);
            if (FN::ROWSTAT) { part += __shfl_xor(part, 16); part += __shfl_xor(part, 32); if (fq == 0) f.rowdone(row, part, -1); }
        }
        __syncthreads();
    }
}

struct TItem { const float* W; const float* gain; bf16_t* WT; int K, N, row_mul, row_off, k0, n0; };
__device__ __forceinline__ void p0_tload(const TItem& t, int lane, float (&w)[32]) {
#pragma unroll
    for (int i = 0; i < 32; ++i) { const int kk = 2 * i + (lane >> 5); float v = t.W[(size_t)(t.k0 + kk) * t.N + t.n0 + (lane & 31)]; if (t.gain) v *= t.gain[t.k0 + kk]; w[i] = v; }
}
__device__ __forceinline__ void p0_tstore(const TItem& t, int lane, LAS float* scr, const float (&w)[32]) {
#pragma unroll
    for (int i = 0; i < 32; ++i) { const int kk = 2 * i + (lane >> 5); scr[kk * 33 + (lane & 31)] = w[i]; }
    LDS_WAIT();
    const int c = lane & 7;
#pragma unroll
    for (int j = 0; j < 4; ++j) { const int n = (lane >> 3) + 8 * j; const LAS float* sp = scr + (8 * c) * 33 + n;
        u32x4 o; o.x = pk2(sp[0 * 33], sp[1 * 33]); o.y = pk2(sp[2 * 33], sp[3 * 33]); o.z = pk2(sp[4 * 33], sp[5 * 33]); o.w = pk2(sp[6 * 33], sp[7 * 33]);
        *(u32x4*)(t.WT + (size_t)(t.row_off + (t.n0 + n) * t.row_mul) * t.K + t.k0 + 8 * c) = o; }
    LDS_WAIT();
}
__device__ __forceinline__ TItem p0_mk(const float* W, int K, int N, bf16_t* WT, int row_mul, int row_off, const float* gain, int item) {
    const int nblk = N / 32; TItem t; t.W = W; t.gain = gain; t.WT = WT; t.K = K; t.N = N; t.row_mul = row_mul; t.row_off = row_off; t.k0 = 64 * (item / nblk); t.n0 = 32 * (item % nblk); return t;
}
__device__ __forceinline__ TItem p0_decode(const Frame& F, int it) {
    unsigned char* ws = F.ws;
    constexpr int I_IN = 16 * 96, I_GV = 8 * 32, I_OUT = 16 * 32, I_F1 = 16 * 128, I_F2 = 64 * 32, I_PLE = 4 * 32, I_PG = 16 * 32, I_POOL = 2 * 8;
    int r = it;
    if (r < I_IN) return p0_mk(F.in[8], D, NZ, (bf16_t*)(ws + WS_WIN), 1, 0, F.in[7], r); r -= I_IN;
    if (r < I_GV) return p0_mk(F.in[19], PW, D, (bf16_t*)(ws + WS_WGLU), 2, 0, nullptr, r); r -= I_GV;
    if (r < I_GV) return p0_mk(F.in[20], PW, D, (bf16_t*)(ws + WS_WGLU), 2, 1, nullptr, r); r -= I_GV;
    if (r < I_OUT) return p0_mk(F.in[21], D, D, (bf16_t*)(ws + WS_WOUT), 1, 0, nullptr, r); r -= I_OUT;
    if (r < I_F1) return p0_mk(F.in[23], D, FF, (bf16_t*)(ws + WS_WFF1), 1, 0, F.in[22], r); r -= I_F1;
    if (r < I_F2) return p0_mk(F.in[24], FF, D, (bf16_t*)(ws + WS_WFF2), 1, 0, nullptr, r); r -= I_F2;
    if (r < I_PLE) return p0_mk(F.in[26], PLE, D, (bf16_t*)(ws + WS_WPLE), 1, 0, nullptr, r); r -= I_PLE;
    if (r < I_PG) return p0_mk(F.in[27], D, D, (bf16_t*)(ws + WS_WPLEG), 1, 0, F.in[25], r); r -= I_PG;
    const int g = r / I_POOL, rr = r % I_POOL;
    return p0_mk(F.in[9] + (size_t)g * 128 * 256, 128, 256, (bf16_t*)(ws + WS_WPOOL), 1, g * 256, nullptr, rr);
}

__device__ __forceinline__ void p0_prologue(const Frame& F) {
    LAS float* scr = (LAS float*)(F.lds + F.wave * 16384);
    unsigned char* ws = F.ws;
    constexpr int NITEMS = 16 * 96 + 2 * 8 * 32 + 16 * 32 + 16 * 128 + 64 * 32 + 4 * 32 + 16 * 32 + 4 * 2 * 8;
    {
        int it = F.gw; float w0[32], w1[32]; TItem t0, t1;
        if (it < NITEMS) { t0 = p0_decode(F, it); p0_tload(t0, F.lane, w0); }
        while (it < NITEMS) {
            const int itn = it + F.NGW;
            if (itn < NITEMS) { t1 = p0_decode(F, itn); p0_tload(t1, F.lane, w1); }
            p0_tstore(t0, F.lane, scr, w0);
            t0 = t1;
#pragma unroll
            for (int i = 0; i < 32; ++i) w0[i] = w1[i];
            it = itn;
        }
    }
    float* ss0 = (float*)(ws + WS_SS);
    bf16_t* XB = (bf16_t*)(ws + WS_R1); bf16_t* PB = (bf16_t*)(ws + WS_PB);
    for (int m0 = F.gw; m0 < MV; m0 += 2 * F.NGW) {
        f32x4 v[2][4], pv[2];
#pragma unroll
        for (int q = 0; q < 2; ++q) {
            const int m = m0 + q * F.NGW;
            if (m < MV) {
                const float* xrow = (m < MPR) ? F.in[0] + (size_t)m * D : F.in[1] + (size_t)(m - MPR) * D;
                const f32x4* xr = (const f32x4*)xrow + F.lane;
#pragma unroll
                for (int j = 0; j < 4; ++j) v[q][j] = xr[64 * j];
                const float* prow = (m < MPR) ? F.in[2] + (size_t)m * PLE : F.in[3] + (size_t)(m - MPR) * PLE;
                pv[q] = ((const f32x4*)prow)[F.lane];
            }
        }
#pragma unroll
        for (int q = 0; q < 2; ++q) {
            const int m = m0 + q * F.NGW;
            if (m < MV) {
                float sq = 0.f;
#pragma unroll
                for (int j = 0; j < 4; ++j) sq += (v[q][j][0] * v[q][j][0] + v[q][j][1] * v[q][j][1]) + (v[q][j][2] * v[q][j][2] + v[q][j][3] * v[q][j][3]);
                sq = wave_sum(sq);
                if (F.lane == 0) ss0[m] = sq;
                u32x2* o8 = (u32x2*)(XB + (size_t)m * D) + F.lane;
#pragma unroll
                for (int j = 0; j < 4; ++j) { u32x2 o; o.x = pk2(v[q][j][0], v[q][j][1]); o.y = pk2(v[q][j][2], v[q][j][3]); o8[64 * j] = o; }
                u32x2 po; po.x = pk2(pv[q][0], pv[q][1]); po.y = pk2(pv[q][2], pv[q][3]);
                ((u32x2*)(PB + (size_t)m * PLE))[F.lane] = po;
            }
        }
    }
    const int gt = blockIdx.x * 512 + F.tid, NGT = F.G * 512;
    { float* ssp = (float*)(ws + WS_SSP); for (int i = gt; i < 3 * MS * 16; i += NGT) { const int a = i / (MS * 16), r = i % (MS * 16); ssp[a * SSP_STRIDE + (size_t)MPR * 16 + r] = 0.f; } }
    for (int i = MV + gt; i < MP; i += NGT) ss0[i] = 1.f;
    for (int i = gt; i < 2048; i += NGT) {
        const int g = i >> 6, p = i & 63;
        const double dt = exp((double)F.in[13][g]), lr = F.in[11][i], li = F.in[12][i];
        const double mag = exp(lr * dt), ang = li * dt, ar = mag * cos(ang), ai = mag * sin(ang);
        const double den = lr * lr + li * li, nr = ar - 1.0, ni = ai;
        const double kr = (nr * lr + ni * li) / den, ki = (ni * lr - nr * li) / den;
        ((float2*)(ws + WS_ABAR))[i] = make_float2((float)ar, (float)ai);
        double pr = ar, pi = ai;
#pragma unroll 1
        for (int s = 0; s < 7; ++s) { const double tr = pr * pr - pi * pi, ti = 2.0 * pr * pi; pr = tr; pi = ti;
            if (s == 3) ((float2*)(ws + WS_A16))[i] = make_float2((float)pr, (float)pi); }
        ((float2*)(ws + WS_A128))[i] = make_float2((float)pr, (float)pi);
        bf16_t* BBT = (bf16_t*)(ws + WS_BBT); bf16_t* CT = (bf16_t*)(ws + WS_CT);
        float* bbfr = (float*)(ws + WS_BBFR); float* bbfi = (float*)(ws + WS_BBFI);
        for (int h = 0; h < 16; ++h) {
            const double br = F.in[14][(size_t)i * 16 + h], bi = F.in[15][(size_t)i * 16 + h];
            const float bbr = (float)(kr * br - ki * bi), bbi = (float)(kr * bi + ki * br);
            bbfr[(size_t)i * 16 + h] = bbr; bbfi[(size_t)i * 16 + h] = bbi;
            BBT[((size_t)g * 128 + (p & 1) * 32 + (p >> 1)) * 16 + h] = (bf16_t)f2bf(bbr);
            BBT[((size_t)g * 128 + (2 + (p & 1)) * 32 + (p >> 1)) * 16 + h] = (bf16_t)f2bf(bbi);
            CT[((size_t)g * 16 + h) * 128 + 4 * (p >> 1) + (p & 1)] = (bf16_t)f2bf(F.in[16][((size_t)g * 16 + h) * 64 + p]);
            CT[((size_t)g * 16 + h) * 128 + 4 * (p >> 1) + 2 + (p & 1)] = (bf16_t)f2bf(-F.in[17][((size_t)g * 16 + h) * 64 + p]);
        }
    }
}

template <int W>
__device__ __forceinline__ void pool_item(const bf16_t* Z, bf16_t* POOLED, int row0, int t0, int grp, int lane) {
    float xa[15 + W], xb[15 + W];
    const int cofs = grp * 128 + 2 * lane;
#pragma unroll
    for (int i = 0; i < 15 + W; ++i) {
        const int dt = i - (W - 1);
        unsigned w = 0u;
        if (t0 + dt >= 0) w = *(const unsigned*)(Z + (size_t)(row0 + dt) * NZ + cofs);
        xa[i] = bflo(w); xb[i] = bfhi(w);
    }
#pragma unroll
    for (int o = 0; o < 16; ++o) {
        float sa = 0.f, sb = 0.f;
#pragma unroll
        for (int j = 0; j < W; ++j) { sa += xa[o + W - 1 - j]; sb += xb[o + W - 1 - j]; }
        const int t = t0 + o; const float inv = 1.0f / (float)((t + 1 < W) ? (t + 1) : W);
        const float ra = sa * inv - xa[o + W - 1], rb = sb * inv - xb[o + W - 1];
        *(unsigned*)(POOLED + (size_t)(row0 + o) * PW + cofs) = pk2(ra, rb);
    }
}

__device__ __forceinline__ float2 cmul(float2 a, float2 b) { return make_float2(a.x * b.x - a.y * b.y, a.x * b.y + a.y * b.x); }
__device__ __forceinline__ float2 cfma(float2 a, float2 h, float2 b) { return make_float2(a.x * h.x - a.y * h.y + b.x, a.x * h.y + a.y * h.x + b.y); }
__device__ __forceinline__ float2 shfl2(float2 v, int src) { return make_float2(__shfl(v.x, src), __shfl(v.y, src)); }

template <int PASS>
__device__ __forceinline__ void scan_item(const Frame& F, int item, LAS unsigned char* wlds) {
    unsigned char* ws = F.ws;
    const int lane = F.lane, n = lane & 31, hh = lane >> 5;
    const int g = item & 31, c = (item >> 5) & 15, b = item >> 9;
    const bf16_t* Z = (const bf16_t*)(ws + WS_Z);
    const bf16_t* BBT = (const bf16_t*)(ws + WS_BBT);
    const float2* ABAR = (const float2*)(ws + WS_ABAR); const float2* A16 = (const float2*)(ws + WS_A16); const float2* A128 = (const float2*)(ws + WS_A128);
    float2* EST = (float2*)(ws + WS_EST);
    const float2 a0 = ABAR[g * 64 + 2 * n], a1 = ABAR[g * 64 + 2 * n + 1];
    const float2 p0 = A16[g * 64 + 2 * n], p1 = A16[g * 64 + 2 * n + 1];
    bf16x8 bfrag[4];
#pragma unroll
    for (int q = 0; q < 4; ++q) bfrag[q] = *(const bf16x8*)(BBT + ((size_t)g * 128 + q * 32 + n) * 16 + 8 * hh);
    float2 H0 = make_float2(0.f, 0.f), H1 = make_float2(0.f, 0.f);
    if (PASS == 2) {
        const float2 q0 = A128[g * 64 + 2 * n], q1 = A128[g * 64 + 2 * n + 1];
        for (int cc = 0; cc < c; ++cc) {
            const float2* e = EST + (((size_t)b * NCHUNK + cc) * 32 + g) * 64 + 2 * n;
            H0 = cfma(q0, H0, e[0]); H1 = cfma(q1, H1, e[1]);
        }
    }
    const int tau = 16 * ((n >> 2) & 1) + 4 * (n >> 3) + (n & 3);
    const size_t rowbase = (size_t)b * SEQ + (size_t)c * CHUNK;
#pragma unroll 1
    for (int tt = 0; tt < 4; ++tt) {
        const size_t trow = rowbase + tt * 32;
        const bf16x8 afrag = *(const bf16x8*)(Z + (trow + tau) * NZ + 512 + g * 16 + 8 * hh);
        f32x16 acc[4];
#pragma unroll
        for (int q = 0; q < 4; ++q) {
#pragma unroll
            for (int r = 0; r < 16; ++r) acc[q][r] = 0.f;
            acc[q] = __builtin_amdgcn_mfma_f32_32x32x16_bf16(afrag, bfrag[q], acc[q], 0, 0, 0);
        }
        float2 e0 = make_float2(0.f, 0.f), e1 = make_float2(0.f, 0.f);
#pragma unroll
        for (int r = 0; r < 16; ++r) { e0 = cfma(a0, e0, make_float2(acc[0][r], acc[2][r])); e1 = cfma(a1, e1, make_float2(acc[1][r], acc[3][r])); }
        const float2 lo0 = shfl2(e0, n), lo1 = shfl2(e1, n), hi0 = shfl2(e0, n + 32), hi1 = shfl2(e1, n + 32);
        const float2 m0 = cfma(p0, H0, lo0), m1 = cfma(p1, H1, lo1);
        if (PASS == 2) {
            float2 k0 = hh ? m0 : H0, k1 = hh ? m1 : H1;
#pragma unroll
            for (int r = 0; r < 16; ++r) {
                k0 = cfma(a0, k0, make_float2(acc[0][r], acc[2][r])); k1 = cfma(a1, k1, make_float2(acc[1][r], acc[3][r]));
                u32x2 o; o.x = pk2(k0.x, k1.x); o.y = pk2(k0.y, k1.y);
                *(LAS u32x2*)(wlds + (16 * hh + r) * 272 + 8 * n) = o;
            }
        }
        H0 = cfma(p0, m0, hi0); H1 = cfma(p1, m1, hi1);
        if (PASS == 2) {
            LDS_WAIT();
            const bf16_t* CT = (const bf16_t*)(ws + WS_CT);
            const int fr = lane & 15, fq = lane >> 4;
            bf16x8 cf[4];
#pragma unroll
            for (int ks = 0; ks < 4; ++ks) cf[ks] = *(const bf16x8*)(CT + ((size_t)g * 16 + fr) * 128 + 32 * ks + 8 * fq);
            const f32x4 dsk = *(const f32x4*)(F.in[18] + g * 16 + 4 * fq);
            bf16_t* GL = (bf16_t*)(ws + WS_GL);
#pragma unroll
            for (int m = 0; m < 2; ++m) {
                f32x4 y = (f32x4){0.f, 0.f, 0.f, 0.f};
#pragma unroll
                for (int ks = 0; ks < 4; ++ks) {
                    const bf16x8 hf = *(const LAS bf16x8*)(wlds + (16 * m + fr) * 272 + 64 * ks + 16 * fq);
                    y = __builtin_amdgcn_mfma_f32_16x16x32_bf16(cf[ks], hf, y, 0, 0, 0);
                }
                const size_t row = trow + 16 * m + fr;
                const u32x2 uu = *(const u32x2*)(Z + row * NZ + 512 + g * 16 + 4 * fq);
                const float s0 = y[0] + dsk[0] * bflo(uu.x), s1 = y[1] + dsk[1] * bfhi(uu.x), s2 = y[2] + dsk[2] * bflo(uu.y), s3 = y[3] + dsk[3] * bfhi(uu.y);
                u32x2 o; o.x = pk2(gelu_tanh(s0), gelu_tanh(s1)); o.y = pk2(gelu_tanh(s2), gelu_tanh(s3));
                *(u32x2*)(GL + row * PW + g * 16 + 4 * fq) = o;
            }
            LDS_WAIT();
        }
    }
    if (PASS == 1) {
        if (hh == 0) { float2* e = EST + (((size_t)b * NCHUNK + c) * 32 + g) * 64 + 2 * n; e[0] = H0; e[1] = H1; }
    } else if (c == NCHUNK - 1) {
        if (hh == 0) {
            float* ore = F.out + O_REP + ((size_t)b * 32 + g) * 64 + 2 * n; float* oim = F.out + O_IMP + ((size_t)b * 32 + g) * 64 + 2 * n;
            ore[0] = H0.x; ore[1] = H1.x; oim[0] = H0.y; oim[1] = H1.y;
        }
    }
}

__device__ __forceinline__ void sample_mixer(const Frame& F) {
    unsigned char* ws = F.ws;
    const bf16_t* Z = (const bf16_t*)(ws + WS_Z);
    bf16_t* POOLED = (bf16_t*)(ws + WS_POOLED); bf16_t* GL = (bf16_t*)(ws + WS_GL);
    const int gt = blockIdx.x * 512 + F.tid, NGT = F.G * 512;
    for (int i = gt; i < MS * PW; i += NGT) {
        const int b = i >> 9, ch = i & 511, grp = ch >> 7, W = 2 << grp;
        const float* st = F.in[4] + (size_t)b * 15 * PW + ch;
        const float u = bflo((unsigned)Z[(size_t)(MPR + b) * NZ + ch]);
        float s = u;
        float* np = F.out + O_POOLS + (size_t)b * 15 * PW + ch;
#pragma unroll
        for (int r = 0; r < 15; ++r) { const float v = st[(size_t)r * PW]; if (r >= 16 - W) s += v; if (r >= 1) np[(size_t)(r - 1) * PW] = v; }
        np[(size_t)14 * PW] = u;
        POOLED[(size_t)(MPR + b) * PW + ch] = (bf16_t)f2bf(s / (float)W - u);
    }
    const float2* ABAR = (const float2*)(ws + WS_ABAR);
    const float* bbfr = (const float*)(ws + WS_BBFR); const float* bbfi = (const float*)(ws + WS_BBFI);
    for (int it = F.gw; it < MS * 32; it += F.NGW) {
        const int b = it >> 5, g = it & 31, p = F.lane;
        const bf16_t* ur = Z + (size_t)(MPR + b) * NZ + 512 + g * 16;
        float u[16];
#pragma unroll
        for (int h = 0; h < 16; ++h) u[h] = bflo((unsigned)ur[h]);
        float br = 0.f, bi = 0.f;
        const f32x4* brp = (const f32x4*)(bbfr + ((size_t)g * 64 + p) * 16); const f32x4* bip = (const f32x4*)(bbfi + ((size_t)g * 64 + p) * 16);
#pragma unroll
        for (int q = 0; q < 4; ++q) { const f32x4 x = brp[q], y = bip[q];
#pragma unroll
            for (int j = 0; j < 4; ++j) { br += x[j] * u[4 * q + j]; bi += y[j] * u[4 * q + j]; } }
        const float2 a = ABAR[g * 64 + p];
        const size_t si = ((size_t)b * 32 + g) * 64 + p;
        const float h0r = F.in[5][si], h0i = F.in[6][si];
        const float hr = a.x * h0r - a.y * h0i + br, hi = a.x * h0i + a.y * h0r + bi;
        F.out[O_RES + si] = hr; F.out[O_IMS + si] = hi;
        float yv = 0.f;
#pragma unroll
        for (int h = 0; h < 16; ++h) {
            const float cr = F.in[16][((size_t)g * 16 + h) * 64 + p], ci = F.in[17][((size_t)g * 16 + h) * 64 + p];
            const float t = wave_sum(cr * hr - ci * hi);
            if (F.lane == h) yv = t + F.in[18][g * 16 + h] * u[h];
        }
        if (F.lane < 16) GL[(size_t)(MPR + b) * PW + g * 16 + F.lane] = (bf16_t)f2bf(gelu_tanh(yv));
    }
}

__global__ void __launch_bounds__(512, 2) fwd_kernel(Args args) {
    extern __shared__ __attribute__((aligned(16))) unsigned char lds_raw[];
    Frame F;
    F.lds = (LAS unsigned char*)lds_raw;
    F.tid = threadIdx.x; F.lane = F.tid & 63; F.wave = __builtin_amdgcn_readfirstlane(F.tid >> 6);
    F.G = gridDim.x; F.gw = blockIdx.x * 8 + F.wave; F.NGW = F.G * 8;
    F.in = args.in; F.out = args.out; F.ws = args.ws;
    unsigned char* ws = args.ws;
    const int lo = args.ph_lo, hi = args.ph_hi;
    volatile LAS unsigned* bst = (volatile LAS unsigned*)(F.lds + 131072 + 1024);
    if (F.tid < 4) bst[F.tid] = 0u;
    __syncthreads();
    XcdBarrier bar; bar.bar = (unsigned*)(ws + WS_BAR); bar.x = 0; bar.st = bst;
    if (args.coop) bar = xcd_barrier_post((unsigned*)(ws + WS_BAR), bst);
    float* SS = (float*)(ws + WS_SS); float* SSP = (float*)(ws + WS_SSP);
    bf16_t* R1 = (bf16_t*)(ws + WS_R1); bf16_t* R2 = (bf16_t*)(ws + WS_R2); bf16_t* Zb = (bf16_t*)(ws + WS_Z);
    bf16_t* POOLED = (bf16_t*)(ws + WS_POOLED); bf16_t* GL = (bf16_t*)(ws + WS_GL); bf16_t* Fb = (bf16_t*)(ws + WS_F);
#define IN(k) (((PHMASK >> (k)) & 1) && lo <= (k) && (k) < hi)
#define SEAM(k) do { if (args.coop && IN(k) && IN((k) + 1)) { if (args.coop == 2) cg::this_grid().sync(); else { xcd_barrier(bar); if (PROBE_BAR) xcd_barrier(bar); } } } while (0)

    if (IN(0)) { p0_prologue(F);
#if PROBE_P0
        p0_prologue(F);
#endif
    }
    SEAM(0);
    if (IN(1)) {
        const bf16_t* W = (const bf16_t*)(ws + WS_WIN);
        pg8::Gemm g{R1, W, MPR, NZ, D, D, D, 0}; pg8::StaticOrder S; S.init(MPR, NZ, F.G, (int)blockIdx.x);
        pg8::EpiStrip<FZ> E{FZ{Zb, SS}};
        pg8::gemm_phase<pg8::EpiStrip<FZ>, true>(F.lds, g, S, E);
        __syncthreads();
        sgemm_phase<FZ, 6, D, NZ>(F, E.f, R1, D, 0, W, D);
#if PROBE_P1
        pg8::gemm_phase<pg8::EpiStrip<FZ>, true>(F.lds, g, S, E);
        __syncthreads();
        sgemm_phase<FZ, 6, D, NZ>(F, E.f, R1, D, 0, W, D);
#endif
    }
    SEAM(1);
    if (IN(2)) {
        for (int rep_ = 0; rep_ < REP_MIX; ++rep_) {
        for (int it = F.gw; it < 4096; it += F.NGW) {
            const int grp = it & 3, tb = it >> 2; const int row0 = tb * 16, t0 = row0 & (SEQ - 1);
            if (grp == 0) pool_item<2>(Zb, POOLED, row0, t0, 0, F.lane);
            else if (grp == 1) pool_item<4>(Zb, POOLED, row0, t0, 1, F.lane);
            else if (grp == 2) pool_item<8>(Zb, POOLED, row0, t0, 2, F.lane);
            else pool_item<16>(Zb, POOLED, row0, t0, 3, F.lane);
        }
        for (int it = F.gw; it < NBATCH * NCHUNK * 32; it += F.NGW) scan_item<1>(F, it, F.lds + F.wave * 16384);
        sample_mixer(F);
        }
        const int gt = blockIdx.x * 512 + F.tid, NGT = F.G * 512;
        for (int i = gt; i < NBATCH * 15 * PW; i += NGT) {
            const int b = i / (15 * PW), r = (i / PW) % 15, ch = i % PW;
            F.out[O_POOLP + i] = bflo((unsigned)Zb[((size_t)b * SEQ + SEQ - 15 + r) * NZ + ch]);
        }
    }
    SEAM(2);
    if (IN(3)) {
        const bf16_t* W = (const bf16_t*)(ws + WS_WPOOL);
        pg8::Gemm g{POOLED, W, MPR, D, 128, PW, 128, 256}; pg8::StaticOrder S; S.init(MPR, D, F.G, (int)blockIdx.x);
        pg8::EpiStrip<FPool> E{FPool{R1, Zb, F.in[10]}};
        pg8::gemm_phase<pg8::EpiStrip<FPool>, true>(F.lds, g, S, E);
#if PROBE_X
        __syncthreads(); pg8::gemm_phase<pg8::EpiStrip<FPool>, true>(F.lds, g, S, E);
#endif
        __syncthreads();
        sgemm_phase<FPool, 2, 128, D>(F, E.f, POOLED, PW, 128, W, 128);
        for (int rep_ = 0; rep_ < REP_MIX; ++rep_)
        for (int it = F.gw; it < NBATCH * NCHUNK * 32; it += F.NGW) scan_item<2>(F, it, F.lds + F.wave * 16384);
    }
    SEAM(3);
    if (IN(4)) {
        const bf16_t* W = (const bf16_t*)(ws + WS_WGLU);
        pg8::Gemm g{GL, W, MPR, 2 * D, PW, PW, PW, 0}; pg8::StaticOrder S; S.init(MPR, 2 * D, F.G, (int)blockIdx.x);
        pg8::EpiStrip<FGlu> E{FGlu{R2, R1, Zb}};
        pg8::gemm_phase<pg8::EpiStrip<FGlu>, true>(F.lds, g, S, E);
#if PROBE_X
        __syncthreads(); pg8::gemm_phase<pg8::EpiStrip<FGlu>, true>(F.lds, g, S, E);
#endif
        __syncthreads();
        sgemm_phase<FGlu, 4, PW, 2 * D>(F, E.f, GL, PW, 0, W, PW);
    }
    SEAM(4);
    if (IN(5)) {
        const bf16_t* W = (const bf16_t*)(ws + WS_WOUT);
        pg8::Gemm g{R2, W, MPR, D, D, D, D, 0}; pg8::StaticOrder S; S.init(MPR, D, F.G, (int)blockIdx.x);
        pg8::EpiStrip<FOut> E{FOut{F.in[0], F.in[1], R1, SSP}};
        pg8::gemm_phase<pg8::EpiStrip<FOut>, true>(F.lds, g, S, E);
        __syncthreads();
        sgemm_phase<FOut, 2, D, D>(F, E.f, R2, D, 0, W, D);
    }
    SEAM(5);
    if (IN(6)) {
        { const bf16_t* W = (const bf16_t*)(ws + WS_WFF1);
          pg8::Gemm g{R1, W, MPR, FF, D, D, D, 0}; pg8::StaticOrder S; S.init(MPR, FF, F.G, (int)blockIdx.x);
          pg8::EpiStrip<FFf1> E{FFf1{Fb, SSP}};
          pg8::gemm_phase<pg8::EpiStrip<FFf1>, true>(F.lds, g, S, E);
          __syncthreads();
          sgemm_phase<FFf1, 8, D, FF>(F, E.f, R1, D, 0, W, D); }
        { const bf16_t* W = (const bf16_t*)(ws + WS_WPLE); const bf16_t* PB = (const bf16_t*)(ws + WS_PB);
          pg8::Gemm g{PB, W, MPR, D, PLE, PLE, PLE, 0}; pg8::StaticOrder S; S.init(MPR, D, F.G, (int)blockIdx.x);
          pg8::EpiStrip<FPle> E{FPle{R2}};
          pg8::gemm_phase<pg8::EpiStrip<FPle>, true>(F.lds, g, S, E);
          __syncthreads();
          sgemm_phase<FPle, 2, PLE, D>(F, E.f, PB, PLE, 0, W, PLE); }
#if PROBE_P6
        { const bf16_t* W = (const bf16_t*)(ws + WS_WFF1);
          pg8::Gemm g{R1, W, MPR, FF, D, D, D, 0}; pg8::StaticOrder S; S.init(MPR, FF, F.G, (int)blockIdx.x);
          pg8::EpiStrip<FFf1> E{FFf1{Fb, SSP}};
          pg8::gemm_phase<pg8::EpiStrip<FFf1>, true>(F.lds, g, S, E);
          __syncthreads();
          sgemm_phase<FFf1, 8, D, FF>(F, E.f, R1, D, 0, W, D); }
        { const bf16_t* W = (const bf16_t*)(ws + WS_WPLE); const bf16_t* PB = (const bf16_t*)(ws + WS_PB);
          pg8::Gemm g{PB, W, MPR, D, PLE, PLE, PLE, 0}; pg8::StaticOrder S; S.init(MPR, D, F.G, (int)blockIdx.x);
          pg8::EpiStrip<FPle> E{FPle{R2}};
          pg8::gemm_phase<pg8::EpiStrip<FPle>, true>(F.lds, g, S, E);
          __syncthreads();
          sgemm_phase<FPle, 2, PLE, D>(F, E.f, PB, PLE, 0, W, PLE); }
#endif
    }
    SEAM(6);
    if (IN(7)) {
        const bf16_t* W = (const bf16_t*)(ws + WS_WFF2);
        pg8::Gemm g{Fb, W, MPR, D, FF, FF, FF, 0}; pg8::StaticOrder S; S.init(MPR, D, F.G, (int)blockIdx.x);
        pg8::EpiStrip<FFf2> E{FFf2{R1, SSP + SSP_STRIDE}};
        pg8::gemm_phase<pg8::EpiStrip<FFf2>, true>(F.lds, g, S, E);
        __syncthreads();
        sgemm_phase<FFf2, 2, FF, D>(F, E.f, Fb, FF, 0, W, FF);
    }
    SEAM(7);
    if (IN(8)) {
        const bf16_t* W = (const bf16_t*)(ws + WS_WPLEG);
        pg8::Gemm g{R1, W, MPR, D, D, D, D, 0}; pg8::StaticOrder S; S.init(MPR, D, F.G, (int)blockIdx.x);
        pg8::EpiStrip<FPleg> E{FPleg{R1, Zb, R2, SSP + SSP_STRIDE, SSP + 2 * SSP_STRIDE}};
        pg8::gemm_phase<pg8::EpiStrip<FPleg>, true>(F.lds, g, S, E);
        __syncthreads();
        sgemm_phase<FPleg, 2, D, D>(F, E.f, R1, D, 0, W, D);
    }
    SEAM(8);
    if (IN(9)) {
        const float* ss3 = SSP + 2 * SSP_STRIDE; const f32x4* gf = (const f32x4*)F.in[28];
        for (int m0 = F.gw; m0 < MV; m0 += 2 * F.NGW) {
            u32x4 v[2][2];
#pragma unroll
            for (int q = 0; q < 2; ++q) { const int m = m0 + q * F.NGW;
                if (m < MV) { const u32x4* xr = (const u32x4*)(Zb + (size_t)m * D) + F.lane; v[q][0] = xr[0]; v[q][1] = xr[64]; } }
#pragma unroll
            for (int q = 0; q < 2; ++q) { const int m = m0 + q * F.NGW;
                if (m < MV) { const float rs = ssp_rstd(ss3, m); f32x4* yr = (f32x4*)(F.out + (size_t)m * D);
#pragma unroll
                    for (int j = 0; j < 2; ++j) { const int c4 = (64 * j + F.lane) * 2;
                        const u32x4 w = v[q][j];
                        f32x4 a = (f32x4){bflo(w.x), bfhi(w.x), bflo(w.y), bfhi(w.y)}, b = (f32x4){bflo(w.z), bfhi(w.z), bflo(w.w), bfhi(w.w)};
                        a = a * rs; b = b * rs; a = a * gf[c4]; b = b * gf[c4 + 1]; yr[c4] = a; yr[c4 + 1] = b; } } }
        }
    }
#undef IN
#undef SEAM
}

extern "C" void kernel_launch(void* const* d_in, const int* in_sizes, int n_in, void* d_out, int out_size, void* d_ws, size_t ws_size, hipStream_t stream) {
    static int grid = 0;
    if (grid == 0) {
        int dev = 0, cus = 0, per_cu = 0;
        hipGetDevice(&dev);
        hipDeviceGetAttribute(&cus, hipDeviceAttributeMultiprocessorCount, dev);
        hipFuncSetAttribute((const void*)fwd_kernel, hipFuncAttributeMaxDynamicSharedMemorySize, LDS_BYTES);
        hipOccupancyMaxActiveBlocksPerMultiprocessor(&per_cu, (const void*)fwd_kernel, 512, LDS_BYTES);
        (void)hipGetLastError();
        if (per_cu < 1) per_cu = 1;
        grid = cus * 1;
        if (grid <= 0) grid = 256;
        if (ws_size < WS_END) { fprintf(stderr, "workspace too small: %zu < %zu\n", ws_size, (size_t)WS_END); }
    }
    Args a{};
    for (int i = 0; i < 29; ++i) a.in[i] = (const float*)d_in[i];
    a.out = (float*)d_out; a.ws = (unsigned char*)d_ws;
#if ONE_LAUNCH
    a.ph_lo = 0; a.ph_hi = 10; a.coop = 1;
    hipMemsetAsync((unsigned char*)d_ws + WS_BAR, 0, BAR_BYTES, stream);
    void* kargs[] = {&a};
    hipError_t e = hipLaunchCooperativeKernel((const void*)fwd_kernel, dim3(grid), dim3(512), kargs, LDS_BYTES, stream);
    if (e != hipSuccess) fprintf(stderr, "cooperative launch failed: %s (grid %d)\n", hipGetErrorString(e), grid);
#else
    for (int ph = 0; ph < 10; ++ph) {
        a.ph_lo = ph; a.ph_hi = ph + 1; a.coop = 0;
        hipLaunchKernelGGL(fwd_kernel, dim3(grid), dim3(512), LDS_BYTES, stream, a);
    }
#endif
}
```

```cpp
#include <hip/hip_runtime.h>
#include <hip/hip_cooperative_groups.h>
#include <cstdio>
#include <cstdint>
namespace cg = cooperative_groups;

#ifndef ONE_LAUNCH
#define ONE_LAUNCH 1
#endif

#ifndef PROBE_P0
#define PROBE_P0 0
#endif
#ifndef PROBE_BAR
#define PROBE_BAR 0
#endif
#ifndef PROBE_P6
#define PROBE_P6 0
#endif
#ifndef PROBE_X
#define PROBE_X 0
#endif
#ifndef PROBE_P1
#define PROBE_P1 0
#endif
#ifndef REP_MIX
#define REP_MIX 1
#endif
#ifndef PHMASK
#define PHMASK 0x3ff
#endif
#define LAS __attribute__((address_space(3)))
typedef unsigned short bf16_t;
typedef short bf16x8 __attribute__((ext_vector_type(8)));
typedef float f32x4 __attribute__((ext_vector_type(4)));
typedef float f32x16 __attribute__((ext_vector_type(16)));
typedef unsigned u32x4 __attribute__((ext_vector_type(4)));
typedef unsigned u32x2 __attribute__((ext_vector_type(2)));

constexpr int D = 1024, NBATCH = 8, SEQ = 2048, MPR = NBATCH * SEQ, MS = 128, MV = MPR + MS, MP = 65 * 256;
constexpr int NZ = 3072, FF = 4096, PLE = 256, PW = 512;
constexpr float EPS = 1e-6f;
constexpr int NCHUNK = 16, CHUNK = 128;
constexpr size_t O_YP = 0, O_YS = 16777216, O_POOLP = 16908288, O_POOLS = 16969728, O_REP = 17952768, O_IMP = 17969152, O_RES = 17985536, O_IMS = 18247680;
constexpr size_t MiB = 1u << 20;
constexpr size_t WS_SS = 0;
constexpr size_t WS_BAR = 512 * 1024;
constexpr size_t BAR_BYTES = 16384;
constexpr size_t WS_ABAR = 1 * MiB;
constexpr size_t WS_A16 = WS_ABAR + 16384, WS_A128 = WS_A16 + 16384;
constexpr size_t WS_BBFR = WS_A128 + 16384;
constexpr size_t WS_BBFI = WS_BBFR + 131072;
constexpr size_t WS_BBT = WS_BBFI + 131072;
constexpr size_t WS_CT = WS_BBT + 131072;
constexpr size_t WS_EST = 2 * MiB;
constexpr size_t WS_WIN = 4 * MiB, WS_WGLU = 10 * MiB, WS_WOUT = 12 * MiB, WS_WFF1 = 14 * MiB, WS_WFF2 = 22 * MiB;
constexpr size_t WS_WPLE = 30 * MiB, WS_WPOOL = 30 * MiB + 512 * 1024, WS_WPLEG = 31 * MiB;
constexpr size_t WS_PB = 33 * MiB;
constexpr size_t WS_R1 = 42 * MiB;
constexpr size_t WS_R2 = 75 * MiB;
constexpr size_t WS_Z = 108 * MiB;
constexpr size_t WS_POOLED = WS_Z + (size_t)MP * NZ * 2;
constexpr size_t WS_GL = WS_POOLED + (size_t)MP * PW * 2;
constexpr size_t WS_F = WS_Z;
constexpr size_t WS_END = WS_GL + (size_t)MP * PW * 2;
constexpr size_t WS_SSP = 240 * MiB;
constexpr size_t SSP_STRIDE = (size_t)MP * 16;
static_assert(WS_END <= WS_SSP && WS_SSP + 3 * SSP_STRIDE * 4 <= 256 * MiB, "ws map");
static_assert(WS_F + (size_t)MP * FF * 2 <= WS_END, "F overlay");

constexpr int LDS_BYTES = 147456;

__device__ __forceinline__ unsigned f2bf(float f) { unsigned u = __builtin_bit_cast(unsigned, f); return (u + 0x7fffu + ((u >> 16) & 1u)) >> 16; }
typedef float f32x2_t __attribute__((ext_vector_type(2))); typedef __bf16 bf16x2_t __attribute__((ext_vector_type(2)));
__device__ __forceinline__ unsigned pk2(float lo, float hi) { f32x2_t v = {lo, hi}; bf16x2_t b = __builtin_convertvector(v, bf16x2_t); return __builtin_bit_cast(unsigned, b); }
__device__ __forceinline__ float bflo(unsigned w) { return __builtin_bit_cast(float, w << 16); }
__device__ __forceinline__ float bfhi(unsigned w) { return __builtin_bit_cast(float, w & 0xffff0000u); }
__device__ __forceinline__ float sigmoidf_(float x) { return __builtin_amdgcn_rcpf(1.0f + __expf(-x)); }
__device__ __forceinline__ float gelu_tanh(float x) { const float u = 1.5957691216f * (x + 0.044715f * x * x * x); return x * sigmoidf_(u); }
__device__ __forceinline__ float wave_sum(float v) {
#pragma unroll
    for (int o = 1; o < 64; o <<= 1) v += __shfl_xor(v, o);
    return v;
}
#define LDS_WAIT() asm volatile("s_waitcnt lgkmcnt(0)" ::: "memory")
#ifndef WT_STORES
#define WT_STORES 0
#endif
__device__ __forceinline__ void st8(void* p, u32x2 v) {
#if WT_STORES
    __hip_atomic_store((unsigned long long*)p, ((unsigned long long)v.y << 32) | (unsigned long long)v.x, __ATOMIC_RELAXED, __HIP_MEMORY_SCOPE_AGENT);
#else
    *(u32x2*)p = v;
#endif
}
__device__ __forceinline__ float ssp_rstd(const float* ssp, int row) {
    const f32x4* q = (const f32x4*)(ssp + (size_t)row * 16); const f32x4 a = q[0], b = q[1], c = q[2], d = q[3];
    const float t = ((a[0] + a[1]) + (a[2] + a[3])) + ((b[0] + b[1]) + (b[2] + b[3])) + ((c[0] + c[1]) + (c[2] + c[3])) + ((d[0] + d[1]) + (d[2] + d[3]));
    return rsqrtf(t * (1.f / 1024.f) + 1e-6f); }
__device__ __forceinline__ void ssp_put(float* ssp, int row, int slot, float p) { if (slot >= 0) ssp[(size_t)row * 16 + slot] = p; else atomicAdd(ssp + (size_t)row * 16, p); }

namespace pg8 {
constexpr int BM = 256, BK = 64, HALF = 128, HTB = HALF * BK * 2, STAGE_BYTES = 8 * HTB, NXCD = 8, WGM = 8;
__host__ __device__ __forceinline__ int lds_byte(int r, int c) { const int st = (r >> 4) * 2 + (c >> 5), rr = r & 15, cc = c & 31, ob = rr * 64 + cc * 2; return st * 1024 + (ob ^ (((ob >> 9) & 1) << 5)); }
__host__ __device__ __forceinline__ void stage_rc(int b, int& R, int& C) { const int st = b / 1024, sb = b % 1024, swz = sb ^ (((sb >> 9) & 1) << 5); R = (st >> 1) * 16 + swz / 64; C = (st & 1) * 32 + (swz % 64) / 2; }
struct Unit { int pm, pn; };
struct Gemm { const bf16_t* A; const bf16_t* Bt; int M, N, K, lda, ldb, a_pn_off; };
struct StaticOrder {
    int nM, nN, nwg, G, c;
    __host__ __device__ void init(int M, int N, int G_, int c_) { nM = M / BM; nN = N / BM; nwg = nM * nN; G = G_; c = c_; }
    __host__ __device__ bool next(int i, Unit& u) const {
        const long L = (long)i * G + c; if (L >= nwg) return false;
        int wgid = (int)L; { const int q = nwg / NXCD, r = nwg % NXCD, xcd = wgid % NXCD, off = wgid / NXCD; wgid = (xcd < r ? xcd * (q + 1) : r * (q + 1) + (xcd - r) * q) + off; }
        const int nig = WGM * nN, gid = wgid / nig, fm = gid * WGM, gsz = (nM - fm) < WGM ? (nM - fm) : WGM;
        u.pm = fm + ((wgid % nig) % gsz); u.pn = (wgid % nig) / gsz; return true;
    }
};

template <class F> struct EpiStrip {
    F f;
    __device__ __forceinline__ void operator()(const f32x4 (&acc)[2][2][4][2], const Unit& u, int wr, int wc, int fr, int fq) const {
#pragma unroll
        for (int ai = 0; ai < 2; ++ai)
#pragma unroll
            for (int m = 0; m < 4; ++m) {
                const int row = u.pm * BM + ai * HALF + wr * 64 + m * 16 + fr;
                const float rs = f.rowinit(row);
                float part = 0.f;
#pragma unroll
                for (int bj = 0; bj < 2; ++bj)
#pragma unroll
                    for (int n = 0; n < 2; ++n) {
                        const int col0 = u.pn * BM + bj * HALF + wc * 32 + n * 16 + 4 * fq;
                        part += f(row, col0, acc[ai][bj][m][n], rs);
                    }
                if (F::ROWSTAT) { part += __shfl_xor(part, 16); part += __shfl_xor(part, 32); if (fq == 0) f.rowdone(row, part, u.pn * 4 + wc); }
            }
    }
};

template <class Epi, bool ALIGN_EPI>
__device__ __forceinline__ void gemm_phase(LAS unsigned char* lds, const Gemm g, const StaticOrder& S, const Epi& E) {
    const int tid = threadIdx.x, wid = __builtin_amdgcn_readfirstlane(tid >> 6), lane = tid & 63, wr = wid >> 2, wc = wid & 3, fr = lane & 15, fq = lane >> 4;
    const int K = g.K; int nt = K / BK; asm volatile("" : "+s"(nt));
    unsigned voffA[2], voffB[2];
#pragma unroll
    for (int i = 0; i < 2; ++i) { int R, C; stage_rc(tid * 16 + i * 8192, R, C);
        voffA[i] = (unsigned)(R * g.lda + C) * 2u; voffB[i] = (unsigned)(R * g.ldb + C) * 2u; }
    const size_t kstep = (size_t)(BK * 2);
    const size_t hstepA = (size_t)HALF * g.lda * 2, hstepB = (size_t)HALF * g.ldb * 2;
    const size_t tstepA = 2 * hstepA, tstepB = 2 * hstepB;
    const unsigned ldsw = (unsigned)wid * 1024u;
    const int aoff = lds_byte(wr * 64 + fr, fq * 8), boff = lds_byte(wc * 32 + fr, fq * 8);
#define PG8_SA(b, h) (((b) * 2 + (h)) * HTB)
#define PG8_SB(b, h) ((4 + (b) * 2 + (h)) * HTB)
#define PG8_STAGE(bufoff, gbase, voff) do { _Pragma("unroll") for (int _i = 0; _i < 2; ++_i) \
        __builtin_amdgcn_global_load_lds((const unsigned*)((const char*)(gbase) + (voff)[_i]), (LAS unsigned*)(lds + (bufoff) + ldsw + _i * 8192), 16, 0, 0); } while (0)
#define PG8_LDA(dst, b, h) do { _Pragma("unroll") for (int m = 0; m < 4; ++m) _Pragma("unroll") for (int k = 0; k < 2; ++k) dst[m][k] = *(const LAS bf16x8*)(lds + PG8_SA(b, h) + aoff + m * 2048 + k * 1024); } while (0)
#define PG8_LDB(dst, b, h) do { _Pragma("unroll") for (int n = 0; n < 2; ++n) _Pragma("unroll") for (int k = 0; k < 2; ++k) dst[n][k] = *(const LAS bf16x8*)(lds + PG8_SB(b, h) + boff + n * 2048 + k * 1024); } while (0)
#define PG8_MMA(ai, bj, At, Bt) do { __builtin_amdgcn_s_setprio(1); _Pragma("unroll") for (int m = 0; m < 4; ++m) _Pragma("unroll") for (int n = 0; n < 2; ++n) _Pragma("unroll") for (int k = 0; k < 2; ++k) \
        acc[ai][bj][m][n] = __builtin_amdgcn_mfma_f32_16x16x32_bf16(Bt[n][k], At[m][k], acc[ai][bj][m][n], 0, 0, 0); __builtin_amdgcn_s_setprio(0); } while (0)
#define PG8_WAIT_V(n) asm volatile("s_waitcnt vmcnt(" #n ")" ::: "memory")
#define PG8_WAIT_L(n) asm volatile("s_waitcnt lgkmcnt(" #n ")" ::: "memory")
#define PG8_BAR __builtin_amdgcn_s_barrier()
#define PG8_SCHED __builtin_amdgcn_sched_barrier(0)
    Unit cur, nxt; int ui = 0;
    if (!S.next(0, cur)) return;
    f32x4 acc[2][2][4][2];
#pragma unroll
    for (int a = 0; a < 2; ++a)
#pragma unroll
        for (int b = 0; b < 2; ++b)
#pragma unroll
            for (int m = 0; m < 4; ++m)
#pragma unroll
                for (int n = 0; n < 2; ++n) acc[a][b][m][n] = (f32x4){0.f, 0.f, 0.f, 0.f};
    bf16x8 At[4][2], B0[2][2], B1[2][2];
    const char* cA = (const char*)g.A + (size_t)cur.pm * tstepA + (size_t)cur.pn * g.a_pn_off; const char* cB = (const char*)g.Bt + (size_t)cur.pn * tstepB;
    PG8_STAGE(PG8_SB(0, 0), cB, voffB); PG8_STAGE(PG8_SB(0, 1), cB + hstepB, voffB); PG8_STAGE(PG8_SA(0, 0), cA, voffA); PG8_STAGE(PG8_SA(0, 1), cA + hstepA, voffA);
    if (wr == 1) PG8_BAR;
    PG8_WAIT_V(2); PG8_BAR;
    PG8_STAGE(PG8_SB(1, 0), cB + kstep, voffB); PG8_STAGE(PG8_SA(1, 0), cA + kstep, voffA); PG8_STAGE(PG8_SB(1, 1), cB + hstepB + kstep, voffB);
    PG8_WAIT_V(6); PG8_BAR;
    for (;;) {
        const bool has_next = S.next(ui + 1, nxt);
        const char* nA = has_next ? (const char*)g.A + (size_t)nxt.pm * tstepA + (size_t)nxt.pn * g.a_pn_off : cA; const char* nB = has_next ? (const char*)g.Bt + (size_t)nxt.pn * tstepB : cB;
        for (int t = 0; t < nt; t += 2) {
            const bool last = (t == nt - 2);
            const char* a1 = cA + (size_t)(t + 1) * kstep;
            const char* a2 = last ? nA : cA + (size_t)(t + 2) * kstep; const char* b2 = last ? nB : cB + (size_t)(t + 2) * kstep;
            const char* a3 = a2 + kstep; const char* b3 = b2 + kstep;
            PG8_LDB(B0, 0, 0); PG8_LDB(B1, 0, 1); PG8_SCHED; PG8_LDA(At, 0, 0); PG8_STAGE(PG8_SA(1, 1), a1 + hstepA, voffA);
            PG8_WAIT_V(8); PG8_WAIT_L(0); PG8_BAR; PG8_MMA(0, 0, At, B0); PG8_MMA(0, 1, At, B1); PG8_BAR; PG8_SCHED;
            PG8_LDA(At, 0, 1); PG8_STAGE(PG8_SB(0, 0), b2, voffB); PG8_STAGE(PG8_SB(0, 1), b2 + hstepB, voffB); PG8_STAGE(PG8_SA(0, 0), a2, voffA);
            PG8_WAIT_V(8); PG8_WAIT_L(0); PG8_BAR; PG8_MMA(1, 0, At, B0); PG8_MMA(1, 1, At, B1); PG8_BAR; PG8_SCHED;
            PG8_LDB(B0, 1, 0); PG8_LDB(B1, 1, 1); PG8_SCHED; PG8_LDA(At, 1, 0); PG8_STAGE(PG8_SA(0, 1), a2 + hstepA, voffA);
            PG8_WAIT_V(8); PG8_WAIT_L(0); PG8_BAR; PG8_MMA(0, 0, At, B0); PG8_MMA(0, 1, At, B1); PG8_BAR; PG8_SCHED;
            PG8_LDA(At, 1, 1); PG8_STAGE(PG8_SB(1, 0), b3, voffB); PG8_STAGE(PG8_SB(1, 1), b3 + hstepB, voffB); PG8_STAGE(PG8_SA(1, 0), a3, voffA);
            PG8_WAIT_V(8); PG8_WAIT_L(0); PG8_BAR; PG8_MMA(1, 0, At, B0); PG8_MMA(1, 1, At, B1); PG8_BAR; PG8_SCHED;
        }
        if constexpr (ALIGN_EPI) { if (wr == 0) PG8_BAR; }
        E(acc, cur, wr, wc, fr, fq);
        if (!has_next) break;
#pragma unroll
        for (int a = 0; a < 2; ++a)
#pragma unroll
            for (int b = 0; b < 2; ++b)
#pragma unroll
                for (int m = 0; m < 4; ++m)
#pragma unroll
                    for (int n = 0; n < 2; ++n) acc[a][b][m][n] = (f32x4){0.f, 0.f, 0.f, 0.f};
        cur = nxt; cA = nA; cB = nB; ++ui;
        if constexpr (ALIGN_EPI) { if (wr == 1) PG8_BAR; }
    }
    PG8_WAIT_V(0);
    if constexpr (!ALIGN_EPI) { if (wr == 0) PG8_BAR; }
    PG8_BAR;
#undef PG8_SA
#undef PG8_SB
#undef PG8_STAGE
#undef PG8_LDA
#undef PG8_LDB
#undef PG8_MMA
#undef PG8_WAIT_V
#undef PG8_WAIT_L
#undef PG8_BAR
#undef PG8_SCHED
}
}

#define XB_TMO      128
#define XB_XCNT(j)  (256  + 64 * (j))
#define XB_XSUB(j)  (1280 + 64 * (j))
#define XB_XGEN(j)  (2304 + 64 * (j))
#define XB_TOP      3328
#define XB_TOPGEN   3392
#define XCD_BAR_WORDS 3456
#define XB_SPIN_CAP (1u << 18)
__device__ __forceinline__ unsigned xb_ld(unsigned* p)              { return __hip_atomic_load(p, __ATOMIC_RELAXED, __HIP_MEMORY_SCOPE_AGENT); }
__device__ __forceinline__ unsigned xb_add(unsigned* p, unsigned v) { return __hip_atomic_fetch_add(p, v, __ATOMIC_RELAXED, __HIP_MEMORY_SCOPE_AGENT); }
__device__ __forceinline__ unsigned xb_xcc_id() { return (unsigned)__builtin_amdgcn_s_getreg((3 << 11) | 20) & 0xFu; }
#define XB_SPIN(cond, bar) do { unsigned _sp = 0; while (cond) { __builtin_amdgcn_s_sleep(1); \
    if ((++_sp & 255u) == 0u) { if (xb_ld(&(bar)[XB_TMO])) break; if (_sp > XB_SPIN_CAP) { atomicAdd(&(bar)[XB_TMO], 1u); break; } } } } while (0)
struct XcdBarrier { unsigned* bar; unsigned x; volatile LAS unsigned* st; };
__device__ __forceinline__ XcdBarrier xcd_barrier_post(unsigned* bar, volatile LAS unsigned* st) {
    XcdBarrier b; b.bar = bar; b.x = xb_xcc_id(); b.st = st;
    if (threadIdx.x == 0) (void)xb_add(&bar[XB_XCNT(b.x)], 1u);
    return b;
}
__device__ __forceinline__ void xcd_barrier_complete(unsigned* bar, unsigned x, unsigned& nloc, unsigned& nx) {
    const unsigned G = gridDim.x * gridDim.y * gridDim.z;
    unsigned sum, cnt, mine, sp = 0u;
    for (;;) {
        sum = 0u; cnt = 0u; mine = 0u;
#pragma unroll
        for (unsigned j = 0; j < 16; ++j) { const unsigned c = xb_ld(&bar[XB_XCNT(j)]); sum += c; cnt += (c > 0u) ? 1u : 0u; mine = (j == x) ? c : mine; }
        if (sum == G) break;
        __builtin_amdgcn_s_sleep(1);
        if ((++sp & 255u) == 0u) { if (xb_ld(&bar[XB_TMO])) break; if (sp > XB_SPIN_CAP) { atomicAdd(&bar[XB_TMO], 1u); break; } }
    }
    nloc = mine > 0u ? mine : 1u; nx = cnt > 0u ? cnt : 1u;
}
__device__ __forceinline__ void xcd_barrier(const XcdBarrier& b) {
    asm volatile("s_waitcnt vmcnt(0)" ::: "memory");
    __syncthreads();
    if (threadIdx.x == 0) {
        unsigned* bar = b.bar;
        __builtin_amdgcn_s_waitcnt(0);
        unsigned nloc = b.st[0], nx = b.st[1];
        if (nloc == 0u) { xcd_barrier_complete(bar, b.x, nloc, nx); b.st[0] = nloc; b.st[1] = nx; }
        const unsigned old = xb_add(&bar[XB_XSUB(b.x)], 1u);
        const unsigned gen = old / nloc;
        if (old + 1u == (gen + 1u) * nloc) {
            __builtin_amdgcn_fence(__ATOMIC_RELEASE, "agent");
            asm volatile("s_waitcnt vmcnt(0)" ::: "memory");
            const unsigned og = xb_add(&bar[XB_TOP], 1u);
            const unsigned tg = og / nx;
            if (og + 1u == (tg + 1u) * nx) xb_add(&bar[XB_TOPGEN], 1u);
            else XB_SPIN(xb_ld(&bar[XB_TOPGEN]) == tg, bar);
            __builtin_amdgcn_fence(__ATOMIC_ACQUIRE, "agent");
            xb_add(&bar[XB_XGEN(b.x)], 1u);
            asm volatile("s_waitcnt vmcnt(0)" ::: "memory");
        } else {
            XB_SPIN(xb_ld(&bar[XB_XGEN(b.x)]) == gen, bar);
            __builtin_amdgcn_fence(__ATOMIC_ACQUIRE, "agent");
            asm volatile("s_waitcnt vmcnt(0)" ::: "memory");
        }
    }
    __syncthreads();
}

struct Args { const float* in[29]; float* out; unsigned char* ws; int ph_lo, ph_hi, coop, pad; };

struct Frame {
    LAS unsigned char* lds;
    int tid, lane, wave, G, gw, NGW;
    const float* const* in; float* out; unsigned char* ws;
};

struct FZ {
    static constexpr bool ROWSTAT = false;
    bf16_t* Z; const float* ss;
    __device__ __forceinline__ float rowinit(int row) const { return rsqrtf(ss[row] * (1.f / D) + EPS); }
    __device__ __forceinline__ float operator()(int row, int col, f32x4 v, float rs) const {
        u32x2 o; o.x = pk2(v[0] * rs, v[1] * rs); o.y = pk2(v[2] * rs, v[3] * rs);
        st8(Z + (size_t)row * NZ + col, o); return 0.f; }
    __device__ __forceinline__ void rowdone(int, float, int) const {}
};
struct FPool {
    static constexpr bool ROWSTAT = false;
    bf16_t* TMP; const bf16_t* Z; const float* pscale;
    __device__ __forceinline__ float rowinit(int) const { return 0.f; }
    __device__ __forceinline__ float operator()(int row, int col, f32x4 v, float) const {
        const u32x2 gz = *(const u32x2*)(Z + (size_t)row * NZ + 1024 + col);
        const f32x4 ps = *(const f32x4*)(pscale + col);
        u32x2 o; o.x = pk2(v[0] * ps[0] * sigmoidf_(bflo(gz.x)), v[1] * ps[1] * sigmoidf_(bfhi(gz.x)));
        o.y = pk2(v[2] * ps[2] * sigmoidf_(bflo(gz.y)), v[3] * ps[3] * sigmoidf_(bfhi(gz.y)));
        st8(TMP + (size_t)row * D + col, o); return 0.f; }
    __device__ __forceinline__ void rowdone(int, float, int) const {}
};
struct FGlu {
    static constexpr bool ROWSTAT = false;
    bf16_t* MG; const bf16_t* TMP; const bf16_t* Z;
    __device__ __forceinline__ float rowinit(int) const { return 0.f; }
    __device__ __forceinline__ float operator()(int row, int col, f32x4 v, float) const {
        const int j = col >> 1;
        const unsigned t = *(const unsigned*)(TMP + (size_t)row * D + j);
        const unsigned gb = *(const unsigned*)(Z + (size_t)row * NZ + 2048 + j);
        const float m0 = bflo(t) + sigmoidf_(bflo(gb)) * v[0] * sigmoidf_(v[1]);
        const float m1 = bfhi(t) + sigmoidf_(bfhi(gb)) * v[2] * sigmoidf_(v[3]);
        *(unsigned*)(MG + (size_t)row * D + j) = pk2(m0, m1); return 0.f; }
    __device__ __forceinline__ void rowdone(int, float, int) const {}
};
struct FOut {
    static constexpr bool ROWSTAT = true;
    const float* xp; const float* xs; bf16_t* XB; float* ss;
    __device__ __forceinline__ float rowinit(int) const { return 0.f; }
    __device__ __forceinline__ float operator()(int row, int col, f32x4 v, float) const {
        f32x4 x = (row < MPR) ? *(const f32x4*)(xp + (size_t)row * D + col) : *(const f32x4*)(xs + (size_t)(row - MPR) * D + col);
        x = x + v;
        u32x2 o; o.x = pk2(x[0], x[1]); o.y = pk2(x[2], x[3]); st8(XB + (size_t)row * D + col, o);
        return (x[0] * x[0] + x[1] * x[1]) + (x[2] * x[2] + x[3] * x[3]); }
    __device__ __forceinline__ void rowdone(int row, float p, int slot) const { ssp_put(ss, row, slot, p); }
};
struct FFf1 {
    static constexpr bool ROWSTAT = false;
    bf16_t* F; const float* ss;
    __device__ __forceinline__ float rowinit(int row) const { return ssp_rstd(ss, row); }
    __device__ __forceinline__ float operator()(int row, int col, f32x4 v, float rs) const {
        float a = fmaxf(v[0] * rs, 0.f), b = fmaxf(v[1] * rs, 0.f), c = fmaxf(v[2] * rs, 0.f), d = fmaxf(v[3] * rs, 0.f);
        u32x2 o; o.x = pk2(a * a, b * b); o.y = pk2(c * c, d * d);
        st8(F + (size_t)row * FF + col, o); return 0.f; }
    __device__ __forceinline__ void rowdone(int, float, int) const {}
};
struct FPle {
    static constexpr bool ROWSTAT = false;
    bf16_t* PL;
    __device__ __forceinline__ float rowinit(int) const { return 0.f; }
    __device__ __forceinline__ float operator()(int row, int col, f32x4 v, float) const {
        u32x2 o; o.x = pk2(v[0], v[1]); o.y = pk2(v[2], v[3]); st8(PL + (size_t)row * D + col, o); return 0.f; }
    __device__ __forceinline__ void rowdone(int, float, int) const {}
};
struct FFf2 {
    static constexpr bool ROWSTAT = true;
    bf16_t* XB; float* ss;
    __device__ __forceinline__ float rowinit(int) const { return 0.f; }
    __device__ __forceinline__ float operator()(int row, int col, f32x4 v, float) const {
        const u32x2 r = *(const u32x2*)(XB + (size_t)row * D + col);
        f32x4 x; x[0] = bflo(r.x) + v[0]; x[1] = bfhi(r.x) + v[1]; x[2] = bflo(r.y) + v[2]; x[3] = bfhi(r.y) + v[3];
        u32x2 o; o.x = pk2(x[0], x[1]); o.y = pk2(x[2], x[3]); st8(XB + (size_t)row * D + col, o);
        return (x[0] * x[0] + x[1] * x[1]) + (x[2] * x[2] + x[3] * x[3]); }
    __device__ __forceinline__ void rowdone(int row, float p, int slot) const { ssp_put(ss, row, slot, p); }
};
struct FPleg {
    static constexpr bool ROWSTAT = true;
    const bf16_t* XB; bf16_t* X3; const bf16_t* PL; const float* ss2; float* ss3;
    __device__ __forceinline__ float rowinit(int row) const { return ssp_rstd(ss2, row); }
    __device__ __forceinline__ float operator()(int row, int col, f32x4 v, float rs) const {
        const u32x2 r = *(const u32x2*)(XB + (size_t)row * D + col);
        const u32x2 pl = *(const u32x2*)(PL + (size_t)row * D + col);
        f32x4 x;
        x[0] = bflo(r.x) + bflo(pl.x) * sigmoidf_(v[0] * rs); x[1] = bfhi(r.x) + bfhi(pl.x) * sigmoidf_(v[1] * rs);
        x[2] = bflo(r.y) + bflo(pl.y) * sigmoidf_(v[2] * rs); x[3] = bfhi(r.y) + bfhi(pl.y) * sigmoidf_(v[3] * rs);
        u32x2 o; o.x = pk2(x[0], x[1]); o.y = pk2(x[2], x[3]); st8(X3 + (size_t)row * D + col, o);
        return (x[0] * x[0] + x[1] * x[1]) + (x[2] * x[2] + x[3] * x[3]); }
    __device__ __forceinline__ void rowdone(int row, float p, int slot) const { ssp_put(ss3, row, slot, p); }
};

template <class FN, int NT, int K, int N>
__device__ __forceinline__ void sgemm_phase(const Frame& Fr, const FN& f, const bf16_t* A, int lda, int a_grp_off, const bf16_t* Bt, int ldb) {
    const int lane = Fr.lane, fr = lane & 15, fq = lane >> 4, w = Fr.wave;
    constexpr int nslab = N / (16 * NT), nitems = 8 * nslab;
    constexpr int KPER = K >= 256 ? K / 8 : 32, KS = KPER / 32;
    constexpr int UBR = 36 / (1 + NT), UB0 = KS < 8 ? KS : 8, UB = UB0 < UBR ? UB0 : UBR;
    static_assert(KS % UB == 0, "sgemm unroll");
    LAS float* red = (LAS float*)Fr.lds;
    for (int it = blockIdx.x; it < nitems; it += Fr.G) {
        const int rt = it & 7, cs = it >> 3;
        const int col_base = cs * 16 * NT;
        const int akoff = (col_base >> 8) * a_grp_off;
        f32x4 acc[NT];
#pragma unroll
        for (int n = 0; n < NT; ++n) acc[n] = (f32x4){0.f, 0.f, 0.f, 0.f};
        const int k0 = w * KPER;
        if (k0 < K) {
            const bf16_t* ap = A + (size_t)(MPR + rt * 16 + fr) * lda + akoff + k0 + 8 * fq;
            const bf16_t* bp = Bt + (size_t)(col_base + fr) * ldb + k0 + 8 * fq;
#pragma unroll
            for (int kb = 0; kb < KS; kb += UB) {
                bf16x8 af[UB], bfr[UB][NT];
#pragma unroll
                for (int u = 0; u < UB; ++u) {
                    af[u] = *(const bf16x8*)(ap + (kb + u) * 32);
#pragma unroll
                    for (int n = 0; n < NT; ++n) bfr[u][n] = *(const bf16x8*)(bp + (size_t)n * 16 * ldb + (kb + u) * 32);
                }
#pragma unroll
                for (int u = 0; u < UB; ++u)
#pragma unroll
                    for (int n = 0; n < NT; ++n) acc[n] = __builtin_amdgcn_mfma_f32_16x16x32_bf16(bfr[u][n], af[u], acc[n], 0, 0, 0);
            }
        }
#pragma unroll
        for (int n = 0; n < NT; ++n) *(LAS f32x4*)(red + ((w * NT + n) * 64 + lane) * 4) = acc[n];
        __syncthreads();
        for (int n = w; n < NT; n += 8) {
            f32x4 sum = (f32x4){0.f, 0.f, 0.f, 0.f};
#pragma unroll
            for (int ww = 0; ww < 8; ++ww) sum = sum + *(const LAS f32x4*)(red + ((ww * NT + n) * 64 + lane) * 4);
            const int row = MPR + rt * 16 + fr, col0 = col_base + n * 16 + 4 * fq;
            const float rs = f.rowinit(row);
            float part = f(row, col0, sum, rs);
            if (FN::ROWSTAT) { part += __shfl_xor(part, 16); part += __shfl_xor(part, 32); if (fq == 0) f.rowdone(row, part, -1); }
        }
        __syncthreads();
    }
}

struct TItem { const float* W; const float* gain; bf16_t* WT; int K, N, row_mul, row_off, k0, n0; };
__device__ __forceinline__ void p0_tload(const TItem& t, int lane, float (&w)[32]) {
#pragma unroll
    for (int i = 0; i < 32; ++i) { const int kk = 2 * i + (lane >> 5); float v = t.W[(size_t)(t.k0 + kk) * t.N + t.n0 + (lane & 31)]; if (t.gain) v *= t.gain[t.k0 + kk]; w[i] = v; }
}
__device__ __forceinline__ void p0_tstore(const TItem& t, int lane, LAS float* scr, const float (&w)[32]) {
#pragma unroll
    for (int i = 0; i < 32; ++i) { const int kk = 2 * i + (lane >> 5); scr[kk * 33 + (lane & 31)] = w[i]; }
    LDS_WAIT();
    const int c = lane & 7;
#pragma unroll
    for (int j = 0; j < 4; ++j) { const int n = (lane >> 3) + 8 * j; const LAS float* sp = scr + (8 * c) * 33 + n;
        u32x4 o; o.x = pk2(sp[0 * 33], sp[1 * 33]); o.y = pk2(sp[2 * 33], sp[3 * 33]); o.z = pk2(sp[4 * 33], sp[5 * 33]); o.w = pk2(sp[6 * 33], sp[7 * 33]);
        *(u32x4*)(t.WT + (size_t)(t.row_off + (t.n0 + n) * t.row_mul) * t.K + t.k0 + 8 * c) = o; }
    LDS_WAIT();
}
__device__ __forceinline__ TItem p0_mk(const float* W, int K, int N, bf16_t* WT, int row_mul, int row_off, const float* gain, int item) {
    const int nblk = N / 32; TItem t; t.W = W; t.gain = gain; t.WT = WT; t.K = K; t.N = N; t.row_mul = row_mul; t.row_off = row_off; t.k0 = 64 * (item / nblk); t.n0 = 32 * (item % nblk); return t;
}
__device__ __forceinline__ TItem p0_decode(const Frame& F, int it) {
    unsigned char* ws = F.ws;
    constexpr int I_IN = 16 * 96, I_GV = 8 * 32, I_OUT = 16 * 32, I_F1 = 16 * 128, I_F2 = 64 * 32, I_PLE = 4 * 32, I_PG = 16 * 32, I_POOL = 2 * 8;
    int r = it;
    if (r < I_IN) return p0_mk(F.in[8], D, NZ, (bf16_t*)(ws + WS_WIN), 1, 0, F.in[7], r); r -= I_IN;
    if (r < I_GV) return p0_mk(F.in[19], PW, D, (bf16_t*)(ws + WS_WGLU), 2, 0, nullptr, r); r -= I_GV;
    if (r < I_GV) return p0_mk(F.in[20], PW, D, (bf16_t*)(ws + WS_WGLU), 2, 1, nullptr, r); r -= I_GV;
    if (r < I_OUT) return p0_mk(F.in[21], D, D, (bf16_t*)(ws + WS_WOUT), 1, 0, nullptr, r); r -= I_OUT;
    if (r < I_F1) return p0_mk(F.in[23], D, FF, (bf16_t*)(ws + WS_WFF1), 1, 0, F.in[22], r); r -= I_F1;
    if (r < I_F2) return p0_mk(F.in[24], FF, D, (bf16_t*)(ws + WS_WFF2), 1, 0, nullptr, r); r -= I_F2;
    if (r < I_PLE) return p0_mk(F.in[26], PLE, D, (bf16_t*)(ws + WS_WPLE), 1, 0, nullptr, r); r -= I_PLE;
    if (r < I_PG) return p0_mk(F.in[27], D, D, (bf16_t*)(ws + WS_WPLEG), 1, 0, F.in[25], r); r -= I_PG;
    const int g = r / I_POOL, rr = r % I_POOL;
    return p0_mk(F.in[9] + (size_t)g * 128 * 256, 128, 256, (bf16_t*)(ws + WS_WPOOL), 1, g * 256, nullptr, rr);
}

__device__ __forceinline__ void p0_prologue(const Frame& F) {
    LAS float* scr = (LAS float*)(F.lds + F.wave * 16384);
    unsigned char* ws = F.ws;
    constexpr int NITEMS = 16 * 96 + 2 * 8 * 32 + 16 * 32 + 16 * 128 + 64 * 32 + 4 * 32 + 16 * 32 + 4 * 2 * 8;
    {
        int it = F.gw; float w0[32], w1[32]; TItem t0, t1;
        if (it < NITEMS) { t0 = p0_decode(F, it); p0_tload(t0, F.lane, w0); }
        while (it < NITEMS) {
            const int itn = it + F.NGW;
            if (itn < NITEMS) { t1 = p0_decode(F, itn); p0_tload(t1, F.lane, w1); }
            p0_tstore(t0, F.lane, scr, w0);
            t0 = t1;
#pragma unroll
            for (int i = 0; i < 32; ++i) w0[i] = w1[i];
            it = itn;
        }
    }
    float* ss0 = (float*)(ws + WS_SS);
    bf16_t* XB = (bf16_t*)(ws + WS_R1); bf16_t* PB = (bf16_t*)(ws + WS_PB);
    for (int m0 = F.gw; m0 < MV; m0 += 2 * F.NGW) {
        f32x4 v[2][4], pv[2];
#pragma unroll
        for (int q = 0; q < 2; ++q) {
            const int m = m0 + q * F.NGW;
            if (m < MV) {
                const float* xrow = (m < MPR) ? F.in[0] + (size_t)m * D : F.in[1] + (size_t)(m - MPR) * D;
                const f32x4* xr = (const f32x4*)xrow + F.lane;
#pragma unroll
                for (int j = 0; j < 4; ++j) v[q][j] = xr[64 * j];
                const float* prow = (m < MPR) ? F.in[2] + (size_t)m * PLE : F.in[3] + (size_t)(m - MPR) * PLE;
                pv[q] = ((const f32x4*)prow)[F.lane];
            }
        }
#pragma unroll
        for (int q = 0; q < 2; ++q) {
            const int m = m0 + q * F.NGW;
            if (m < MV) {
                float sq = 0.f;
#pragma unroll
                for (int j = 0; j < 4; ++j) sq += (v[q][j][0] * v[q][j][0] + v[q][j][1] * v[q][j][1]) + (v[q][j][2] * v[q][j][2] + v[q][j][3] * v[q][j][3]);
                sq = wave_sum(sq);
                if (F.lane == 0) ss0[m] = sq;
                u32x2* o8 = (u32x2*)(XB + (size_t)m * D) + F.lane;
#pragma unroll
                for (int j = 0; j < 4; ++j) { u32x2 o; o.x = pk2(v[q][j][0], v[q][j][1]); o.y = pk2(v[q][j][2], v[q][j][3]); o8[64 * j] = o; }
                u32x2 po; po.x = pk2(pv[q][0], pv[q][1]); po.y = pk2(pv[q][2], pv[q][3]);
                ((u32x2*)(PB + (size_t)m * PLE))[F.lane] = po;
            }
        }
    }
    const int gt = blockIdx.x * 512 + F.tid, NGT = F.G * 512;
    { float* ssp = (float*)(ws + WS_SSP); for (int i = gt; i < 3 * MS * 16; i += NGT) { const int a = i / (MS * 16), r = i % (MS * 16); ssp[a * SSP_STRIDE + (size_t)MPR * 16 + r] = 0.f; } }
    for (int i = MV + gt; i < MP; i += NGT) ss0[i] = 1.f;
    for (int i = gt; i < 2048; i += NGT) {
        const int g = i >> 6, p = i & 63;
        const double dt = exp((double)F.in[13][g]), lr = F.in[11][i], li = F.in[12][i];
        const double mag = exp(lr * dt), ang = li * dt, ar = mag * cos(ang), ai = mag * sin(ang);
        const double den = lr * lr + li * li, nr = ar - 1.0, ni = ai;
        const double kr = (nr * lr + ni * li) / den, ki = (ni * lr - nr * li) / den;
        ((float2*)(ws + WS_ABAR))[i] = make_float2((float)ar, (float)ai);
        double pr = ar, pi = ai;
#pragma unroll 1
        for (int s = 0; s < 7; ++s) { const double tr = pr * pr - pi * pi, ti = 2.0 * pr * pi; pr = tr; pi = ti;
            if (s == 3) ((float2*)(ws + WS_A16))[i] = make_float2((float)pr, (float)pi); }
        ((float2*)(ws + WS_A128))[i] = make_float2((float)pr, (float)pi);
        bf16_t* BBT = (bf16_t*)(ws + WS_BBT); bf16_t* CT = (bf16_t*)(ws + WS_CT);
        float* bbfr = (float*)(ws + WS_BBFR); float* bbfi = (float*)(ws + WS_BBFI);
        for (int h = 0; h < 16; ++h) {
            const double br = F.in[14][(size_t)i * 16 + h], bi = F.in[15][(size_t)i * 16 + h];
            const float bbr = (float)(kr * br - ki * bi), bbi = (float)(kr * bi + ki * br);
            bbfr[(size_t)i * 16 + h] = bbr; bbfi[(size_t)i * 16 + h] = bbi;
            BBT[((size_t)g * 128 + (p & 1) * 32 + (p >> 1)) * 16 + h] = (bf16_t)f2bf(bbr);
            BBT[((size_t)g * 128 + (2 + (p & 1)) * 32 + (p >> 1)) * 16 + h] = (bf16_t)f2bf(bbi);
            CT[((size_t)g * 16 + h) * 128 + 4 * (p >> 1) + (p & 1)] = (bf16_t)f2bf(F.in[16][((size_t)g * 16 + h) * 64 + p]);
            CT[((size_t)g * 16 + h) * 128 + 4 * (p >> 1) + 2 + (p & 1)] = (bf16_t)f2bf(-F.in[17][((size_t)g * 16 + h) * 64 + p]);
        }
    }
}

template <int W>
__device__ __forceinline__ void pool_item(const bf16_t* Z, bf16_t* POOLED, int row0, int t0, int grp, int lane) {
    float xa[15 + W], xb[15 + W];
    const int cofs = grp * 128 + 2 * lane;
#pragma unroll
    for (int i = 0; i < 15 + W; ++i) {
        const int dt = i - (W - 1);
        unsigned w = 0u;
        if (t0 + dt >= 0) w = *(const unsigned*)(Z + (size_t)(row0 + dt) * NZ + cofs);
        xa[i] = bflo(w); xb[i] = bfhi(w);
    }
#pragma unroll
    for (int o = 0; o < 16; ++o) {
        float sa = 0.f, sb = 0.f;
#pragma unroll
        for (int j = 0; j < W; ++j) { sa += xa[o + W - 1 - j]; sb += xb[o + W - 1 - j]; }
        const int t = t0 + o; const float inv = 1.0f / (float)((t + 1 < W) ? (t + 1) : W);
        const float ra = sa * inv - xa[o + W - 1], rb = sb * inv - xb[o + W - 1];
        *(unsigned*)(POOLED + (size_t)(row0 + o) * PW + cofs) = pk2(ra, rb);
    }
}

__device__ __forceinline__ float2 cmul(float2 a, float2 b) { return make_float2(a.x * b.x - a.y * b.y, a.x * b.y + a.y * b.x); }
__device__ __forceinline__ float2 cfma(float2 a, float2 h, float2 b) { return make_float2(a.x * h.x - a.y * h.y + b.x, a.x * h.y + a.y * h.x + b.y); }
__device__ __forceinline__ float2 shfl2(float2 v, int src) { return make_float2(__shfl(v.x, src), __shfl(v.y, src)); }

template <int PASS>
__device__ __forceinline__ void scan_item(const Frame& F, int item, LAS unsigned char* wlds) {
    unsigned char* ws = F.ws;
    const int lane = F.lane, n = lane & 31, hh = lane >> 5;
    const int g = item & 31, c = (item >> 5) & 15, b = item >> 9;
    const bf16_t* Z = (const bf16_t*)(ws + WS_Z);
    const bf16_t* BBT = (const bf16_t*)(ws + WS_BBT);
    const float2* ABAR = (const float2*)(ws + WS_ABAR); const float2* A16 = (const float2*)(ws + WS_A16); const float2* A128 = (const float2*)(ws + WS_A128);
    float2* EST = (float2*)(ws + WS_EST);
    const float2 a0 = ABAR[g * 64 + 2 * n], a1 = ABAR[g * 64 + 2 * n + 1];
    const float2 p0 = A16[g * 64 + 2 * n], p1 = A16[g * 64 + 2 * n + 1];
    bf16x8 bfrag[4];
#pragma unroll
    for (int q = 0; q < 4; ++q) bfrag[q] = *(const bf16x8*)(BBT + ((size_t)g * 128 + q * 32 + n) * 16 + 8 * hh);
    float2 H0 = make_float2(0.f, 0.f), H1 = make_float2(0.f, 0.f);
    if (PASS == 2) {
        const float2 q0 = A128[g * 64 + 2 * n], q1 = A128[g * 64 + 2 * n + 1];
        float2 ev0[NCHUNK - 1], ev1[NCHUNK - 1];
#pragma unroll
        for (int cc = 0; cc < NCHUNK - 1; ++cc) {
            const int ci = cc < c ? cc : 0;
            const float2* e = EST + (((size_t)b * NCHUNK + ci) * 32 + g) * 64 + 2 * n;
            ev0[cc] = e[0]; ev1[cc] = e[1];
        }
#pragma unroll
        for (int cc = 0; cc < NCHUNK - 1; ++cc) if (cc < c) { H0 = cfma(q0, H0, ev0[cc]); H1 = cfma(q1, H1, ev1[cc]); }
    }
    const int tau = 16 * ((n >> 2) & 1) + 4 * (n >> 3) + (n & 3);
    const size_t rowbase = (size_t)b * SEQ + (size_t)c * CHUNK;
#pragma unroll 1
    for (int tt = 0; tt < 4; ++tt) {
        const size_t trow = rowbase + tt * 32;
        const bf16x8 afrag = *(const bf16x8*)(Z + (trow + tau) * NZ + 512 + g * 16 + 8 * hh);
        f32x16 acc[4];
#pragma unroll
        for (int q = 0; q < 4; ++q) {
#pragma unroll
            for (int r = 0; r < 16; ++r) acc[q][r] = 0.f;
            acc[q] = __builtin_amdgcn_mfma_f32_32x32x16_bf16(afrag, bfrag[q], acc[q], 0, 0, 0);
        }
        float2 e0 = make_float2(0.f, 0.f), e1 = make_float2(0.f, 0.f);
#pragma unroll
        for (int r = 0; r < 16; ++r) { e0 = cfma(a0, e0, make_float2(acc[0][r], acc[2][r])); e1 = cfma(a1, e1, make_float2(acc[1][r], acc[3][r])); }
        const float2 lo0 = shfl2(e0, n), lo1 = shfl2(e1, n), hi0 = shfl2(e0, n + 32), hi1 = shfl2(e1, n + 32);
        const float2 m0 = cfma(p0, H0, lo0), m1 = cfma(p1, H1, lo1);
        if (PASS == 2) {
            float2 k0 = hh ? m0 : H0, k1 = hh ? m1 : H1;
#pragma unroll
            for (int r = 0; r < 16; ++r) {
                k0 = cfma(a0, k0, make_float2(acc[0][r], acc[2][r])); k1 = cfma(a1, k1, make_float2(acc[1][r], acc[3][r]));
                u32x2 o; o.x = pk2(k0.x, k1.x); o.y = pk2(k0.y, k1.y);
                *(LAS u32x2*)(wlds + (16 * hh + r) * 272 + 8 * n) = o;
            }
        }
        H0 = cfma(p0, m0, hi0); H1 = cfma(p1, m1, hi1);
        if (PASS == 2) {
            LDS_WAIT();
            const bf16_t* CT = (const bf16_t*)(ws + WS_CT);
            const int fr = lane & 15, fq = lane >> 4;
            bf16x8 cf[4];
#pragma unroll
            for (int ks = 0; ks < 4; ++ks) cf[ks] = *(const bf16x8*)(CT + ((size_t)g * 16 + fr) * 128 + 32 * ks + 8 * fq);
            const f32x4 dsk = *(const f32x4*)(F.in[18] + g * 16 + 4 * fq);
            bf16_t* GL = (bf16_t*)(ws + WS_GL);
#pragma unroll
            for (int m = 0; m < 2; ++m) {
                f32x4 y = (f32x4){0.f, 0.f, 0.f, 0.f};
#pragma unroll
                for (int ks = 0; ks < 4; ++ks) {
                    const bf16x8 hf = *(const LAS bf16x8*)(wlds + (16 * m + fr) * 272 + 64 * ks + 16 * fq);
                    y = __builtin_amdgcn_mfma_f32_16x16x32_bf16(cf[ks], hf, y, 0, 0, 0);
                }
                const size_t row = trow + 16 * m + fr;
                const u32x2 uu = *(const u32x2*)(Z + row * NZ + 512 + g * 16 + 4 * fq);
                const float s0 = y[0] + dsk[0] * bflo(uu.x), s1 = y[1] + dsk[1] * bfhi(uu.x), s2 = y[2] + dsk[2] * bflo(uu.y), s3 = y[3] + dsk[3] * bfhi(uu.y);
                u32x2 o; o.x = pk2(gelu_tanh(s0), gelu_tanh(s1)); o.y = pk2(gelu_tanh(s2), gelu_tanh(s3));
                *(u32x2*)(GL + row * PW + g * 16 + 4 * fq) = o;
            }
            LDS_WAIT();
        }
    }
    if (PASS == 1) {
        if (hh == 0) { float2* e = EST + (((size_t)b * NCHUNK + c) * 32 + g) * 64 + 2 * n; e[0] = H0; e[1] = H1; }
    } else if (c == NCHUNK - 1) {
        if (hh == 0) {
            float* ore = F.out + O_REP + ((size_t)b * 32 + g) * 64 + 2 * n; float* oim = F.out + O_IMP + ((size_t)b * 32 + g) * 64 + 2 * n;
            ore[0] = H0.x; ore[1] = H1.x; oim[0] = H0.y; oim[1] = H1.y;
        }
    }
}

__device__ __forceinline__ void sample_mixer(const Frame& F) {
    unsigned char* ws = F.ws;
    const bf16_t* Z = (const bf16_t*)(ws + WS_Z);
    bf16_t* POOLED = (bf16_t*)(ws + WS_POOLED); bf16_t* GL = (bf16_t*)(ws + WS_GL);
    const int gt = blockIdx.x * 512 + F.tid, NGT = F.G * 512;
    for (int i = gt; i < MS * PW; i += NGT) {
        const int b = i >> 9, ch = i & 511, grp = ch >> 7, W = 2 << grp;
        const float* st = F.in[4] + (size_t)b * 15 * PW + ch;
        const float u = bflo((unsigned)Z[(size_t)(MPR + b) * NZ + ch]);
        float s = u;
        float* np = F.out + O_POOLS + (size_t)b * 15 * PW + ch;
#pragma unroll
        for (int r = 0; r < 15; ++r) { const float v = st[(size_t)r * PW]; if (r >= 16 - W) s += v; if (r >= 1) np[(size_t)(r - 1) * PW] = v; }
        np[(size_t)14 * PW] = u;
        POOLED[(size_t)(MPR + b) * PW + ch] = (bf16_t)f2bf(s / (float)W - u);
    }
    const float2* ABAR = (const float2*)(ws + WS_ABAR);
    const float* bbfr = (const float*)(ws + WS_BBFR); const float* bbfi = (const float*)(ws + WS_BBFI);
    for (int it = F.gw; it < MS * 32; it += F.NGW) {
        const int b = it >> 5, g = it & 31, p = F.lane;
        const bf16_t* ur = Z + (size_t)(MPR + b) * NZ + 512 + g * 16;
        float u[16];
#pragma unroll
        for (int h = 0; h < 16; ++h) u[h] = bflo((unsigned)ur[h]);
        float br = 0.f, bi = 0.f;
        const f32x4* brp = (const f32x4*)(bbfr + ((size_t)g * 64 + p) * 16); const f32x4* bip = (const f32x4*)(bbfi + ((size_t)g * 64 + p) * 16);
#pragma unroll
        for (int q = 0; q < 4; ++q) { const f32x4 x = brp[q], y = bip[q];
#pragma unroll
            for (int j = 0; j < 4; ++j) { br += x[j] * u[4 * q + j]; bi += y[j] * u[4 * q + j]; } }
        const float2 a = ABAR[g * 64 + p];
        const size_t si = ((size_t)b * 32 + g) * 64 + p;
        const float h0r = F.in[5][si], h0i = F.in[6][si];
        const float hr = a.x * h0r - a.y * h0i + br, hi = a.x * h0i + a.y * h0r + bi;
        F.out[O_RES + si] = hr; F.out[O_IMS + si] = hi;
        float yv = 0.f;
#pragma unroll
        for (int h = 0; h < 16; ++h) {
            const float cr = F.in[16][((size_t)g * 16 + h) * 64 + p], ci = F.in[17][((size_t)g * 16 + h) * 64 + p];
            const float t = wave_sum(cr * hr - ci * hi);
            if (F.lane == h) yv = t + F.in[18][g * 16 + h] * u[h];
        }
        if (F.lane < 16) GL[(size_t)(MPR + b) * PW + g * 16 + F.lane] = (bf16_t)f2bf(gelu_tanh(yv));
    }
}

__global__ void __launch_bounds__(512, 2) fwd_kernel(Args args) {
    extern __shared__ __attribute__((aligned(16))) unsigned char lds_raw[];
    Frame F;
    F.lds = (LAS unsigned char*)lds_raw;
    F.tid = threadIdx.x; F.lane = F.tid & 63; F.wave = __builtin_amdgcn_readfirstlane(F.tid >> 6);
    F.G = gridDim.x; F.gw = blockIdx.x * 8 + F.wave; F.NGW = F.G * 8;
    F.in = args.in; F.out = args.out; F.ws = args.ws;
    unsigned char* ws = args.ws;
    const int lo = args.ph_lo, hi = args.ph_hi;
    volatile LAS unsigned* bst = (volatile LAS unsigned*)(F.lds + 131072 + 1024);
    if (F.tid < 4) bst[F.tid] = 0u;
    __syncthreads();
    XcdBarrier bar; bar.bar = (unsigned*)(ws + WS_BAR); bar.x = 0; bar.st = bst;
    if (args.coop) bar = xcd_barrier_post((unsigned*)(ws + WS_BAR), bst);
    float* SS = (float*)(ws + WS_SS); float* SSP = (float*)(ws + WS_SSP);
    bf16_t* R1 = (bf16_t*)(ws + WS_R1); bf16_t* R2 = (bf16_t*)(ws + WS_R2); bf16_t* Zb = (bf16_t*)(ws + WS_Z);
    bf16_t* POOLED = (bf16_t*)(ws + WS_POOLED); bf16_t* GL = (bf16_t*)(ws + WS_GL); bf16_t* Fb = (bf16_t*)(ws + WS_F);
#define IN(k) (((PHMASK >> (k)) & 1) && lo <= (k) && (k) < hi)
#define SEAM(k) do { if (args.coop && IN(k) && IN((k) + 1)) { if (args.coop == 2) cg::this_grid().sync(); else { xcd_barrier(bar); if (PROBE_BAR) xcd_barrier(bar); } } } while (0)

    if (IN(0)) { p0_prologue(F);
#if PROBE_P0
        p0_prologue(F);
#endif
    }
    SEAM(0);
    if (IN(1)) {
        const bf16_t* W = (const bf16_t*)(ws + WS_WIN);
        pg8::Gemm g{R1, W, MPR, NZ, D, D, D, 0}; pg8::StaticOrder S; S.init(MPR, NZ, F.G, (int)blockIdx.x);
        pg8::EpiStrip<FZ> E{FZ{Zb, SS}};
        pg8::gemm_phase<pg8::EpiStrip<FZ>, true>(F.lds, g, S, E);
        __syncthreads();
        sgemm_phase<FZ, 6, D, NZ>(F, E.f, R1, D, 0, W, D);
#if PROBE_P1
        pg8::gemm_phase<pg8::EpiStrip<FZ>, true>(F.lds, g, S, E);
        __syncthreads();
        sgemm_phase<FZ, 6, D, NZ>(F, E.f, R1, D, 0, W, D);
#endif
    }
    SEAM(1);
    if (IN(2)) {
        for (int rep_ = 0; rep_ < REP_MIX; ++rep_) {
        for (int it = F.gw; it < 4096; it += F.NGW) {
            const int grp = it & 3, tb = it >> 2; const int row0 = tb * 16, t0 = row0 & (SEQ - 1);
            if (grp == 0) pool_item<2>(Zb, POOLED, row0, t0, 0, F.lane);
            else if (grp == 1) pool_item<4>(Zb, POOLED, row0, t0, 1, F.lane);
            else if (grp == 2) pool_item<8>(Zb, POOLED, row0, t0, 2, F.lane);
            else pool_item<16>(Zb, POOLED, row0, t0, 3, F.lane);
        }
        for (int it = F.gw; it < NBATCH * NCHUNK * 32; it += F.NGW) scan_item<1>(F, it, F.lds + F.wave * 16384);
        sample_mixer(F);
        }
        const int gt = blockIdx.x * 512 + F.tid, NGT = F.G * 512;
        for (int i = gt; i < NBATCH * 15 * PW; i += NGT) {
            const int b = i / (15 * PW), r = (i / PW) % 15, ch = i % PW;
            F.out[O_POOLP + i] = bflo((unsigned)Zb[((size_t)b * SEQ + SEQ - 15 + r) * NZ + ch]);
        }
    }
    SEAM(2);
    if (IN(3)) {
        const bf16_t* W = (const bf16_t*)(ws + WS_WPOOL);
        pg8::Gemm g{POOLED, W, MPR, D, 128, PW, 128, 256}; pg8::StaticOrder S; S.init(MPR, D, F.G, (int)blockIdx.x);
        pg8::EpiStrip<FPool> E{FPool{R1, Zb, F.in[10]}};
        pg8::gemm_phase<pg8::EpiStrip<FPool>, true>(F.lds, g, S, E);
#if PROBE_X
        __syncthreads(); pg8::gemm_phase<pg8::EpiStrip<FPool>, true>(F.lds, g, S, E);
#endif
        __syncthreads();
        sgemm_phase<FPool, 2, 128, D>(F, E.f, POOLED, PW, 128, W, 128);
        for (int rep_ = 0; rep_ < REP_MIX; ++rep_)
        for (int it = F.gw; it < NBATCH * NCHUNK * 32; it += F.NGW) scan_item<2>(F, it, F.lds + F.wave * 16384);
    }
    SEAM(3);
    if (IN(4)) {
        const bf16_t* W = (const bf16_t*)(ws + WS_WGLU);
        pg8::Gemm g{GL, W, MPR, 2 * D, PW, PW, PW, 0}; pg8::StaticOrder S; S.init(MPR, 2 * D, F.G, (int)blockIdx.x);
        pg8::EpiStrip<FGlu> E{FGlu{R2, R1, Zb}};
        pg8::gemm_phase<pg8::EpiStrip<FGlu>, true>(F.lds, g, S, E);
#if PROBE_X
        __syncthreads(); pg8::gemm_phase<pg8::EpiStrip<FGlu>, true>(F.lds, g, S, E);
#endif
        __syncthreads();
        sgemm_phase<FGlu, 4, PW, 2 * D>(F, E.f, GL, PW, 0, W, PW);
    }
    SEAM(4);
    if (IN(5)) {
        const bf16_t* W = (const bf16_t*)(ws + WS_WOUT);
        pg8::Gemm g{R2, W, MPR, D, D, D, D, 0}; pg8::StaticOrder S; S.init(MPR, D, F.G, (int)blockIdx.x);
        pg8::EpiStrip<FOut> E{FOut{F.in[0], F.in[1], R1, SSP}};
        pg8::gemm_phase<pg8::EpiStrip<FOut>, true>(F.lds, g, S, E);
        __syncthreads();
        sgemm_phase<FOut, 2, D, D>(F, E.f, R2, D, 0, W, D);
    }
    SEAM(5);
    if (IN(6)) {
        { const bf16_t* W = (const bf16_t*)(ws + WS_WFF1);
          pg8::Gemm g{R1, W, MPR, FF, D, D, D, 0}; pg8::StaticOrder S; S.init(MPR, FF, F.G, (int)blockIdx.x);
          pg8::EpiStrip<FFf1> E{FFf1{Fb, SSP}};
          pg8::gemm_phase<pg8::EpiStrip<FFf1>, true>(F.lds, g, S, E);
          __syncthreads();
          sgemm_phase<FFf1, 8, D, FF>(F, E.f, R1, D, 0, W, D); }
        { const bf16_t* W = (const bf16_t*)(ws + WS_WPLE); const bf16_t* PB = (const bf16_t*)(ws + WS_PB);
          pg8::Gemm g{PB, W, MPR, D, PLE, PLE, PLE, 0}; pg8::StaticOrder S; S.init(MPR, D, F.G, (int)blockIdx.x);
          pg8::EpiStrip<FPle> E{FPle{R2}};
          pg8::gemm_phase<pg8::EpiStrip<FPle>, true>(F.lds, g, S, E);
          __syncthreads();
          sgemm_phase<FPle, 2, PLE, D>(F, E.f, PB, PLE, 0, W, PLE); }
#if PROBE_P6
        { const bf16_t* W = (const bf16_t*)(ws + WS_WFF1);
          pg8::Gemm g{R1, W, MPR, FF, D, D, D, 0}; pg8::StaticOrder S; S.init(MPR, FF, F.G, (int)blockIdx.x);
          pg8::EpiStrip<FFf1> E{FFf1{Fb, SSP}};
          pg8::gemm_phase<pg8::EpiStrip<FFf1>, true>(F.lds, g, S, E);
          __syncthreads();
          sgemm_phase<FFf1, 8, D, FF>(F, E.f, R1, D, 0, W, D); }
        { const bf16_t* W = (const bf16_t*)(ws + WS_WPLE); const bf16_t* PB = (const bf16_t*)(ws + WS_PB);
          pg8::Gemm g{PB, W, MPR, D, PLE, PLE, PLE, 0}; pg8::StaticOrder S; S.init(MPR, D, F.G, (int)blockIdx.x);
          pg8::EpiStrip<FPle> E{FPle{R2}};
          pg8::gemm_phase<pg8::EpiStrip<FPle>, true>(F.lds, g, S, E);
          __syncthreads();
          sgemm_phase<FPle, 2, PLE, D>(F, E.f, PB, PLE, 0, W, PLE); }
#endif
    }
    SEAM(6);
    if (IN(7)) {
        const bf16_t* W = (const bf16_t*)(ws + WS_WFF2);
        pg8::Gemm g{Fb, W, MPR, D, FF, FF, FF, 0}; pg8::StaticOrder S; S.init(MPR, D, F.G, (int)blockIdx.x);
        pg8::EpiStrip<FFf2> E{FFf2{R1, SSP + SSP_STRIDE}};
        pg8::gemm_phase<pg8::EpiStrip<FFf2>, true>(F.lds, g, S, E);
        __syncthreads();
        sgemm_phase<FFf2, 2, FF, D>(F, E.f, Fb, FF, 0, W, FF);
    }
    SEAM(7);
    if (IN(8)) {
        const bf16_t* W = (const bf16_t*)(ws + WS_WPLEG);
        pg8::Gemm g{R1, W, MPR, D, D, D, D, 0}; pg8::StaticOrder S; S.init(MPR, D, F.G, (int)blockIdx.x);
        pg8::EpiStrip<FPleg> E{FPleg{R1, Zb, R2, SSP + SSP_STRIDE, SSP + 2 * SSP_STRIDE}};
        pg8::gemm_phase<pg8::EpiStrip<FPleg>, true>(F.lds, g, S, E);
        __syncthreads();
        sgemm_phase<FPleg, 2, D, D>(F, E.f, R1, D, 0, W, D);
    }
    SEAM(8);
    if (IN(9)) {
        const float* ss3 = SSP + 2 * SSP_STRIDE; const f32x4* gf = (const f32x4*)F.in[28];
        for (int m0 = F.gw; m0 < MV; m0 += 2 * F.NGW) {
            u32x4 v[2][2];
#pragma unroll
            for (int q = 0; q < 2; ++q) { const int m = m0 + q * F.NGW;
                if (m < MV) { const u32x4* xr = (const u32x4*)(Zb + (size_t)m * D) + F.lane; v[q][0] = xr[0]; v[q][1] = xr[64]; } }
#pragma unroll
            for (int q = 0; q < 2; ++q) { const int m = m0 + q * F.NGW;
                if (m < MV) { const float rs = ssp_rstd(ss3, m); f32x4* yr = (f32x4*)(F.out + (size_t)m * D);
#pragma unroll
                    for (int j = 0; j < 2; ++j) { const int c4 = (64 * j + F.lane) * 2;
                        const u32x4 w = v[q][j];
                        f32x4 a = (f32x4){bflo(w.x), bfhi(w.x), bflo(w.y), bfhi(w.y)}, b = (f32x4){bflo(w.z), bfhi(w.z), bflo(w.w), bfhi(w.w)};
                        a = a * rs; b = b * rs; a = a * gf[c4]; b = b * gf[c4 + 1]; yr[c4] = a; yr[c4 + 1] = b; } } }
        }
    }
#undef IN
#undef SEAM
}

extern "C" void kernel_launch(void* const* d_in, const int* in_sizes, int n_in, void* d_out, int out_size, void* d_ws, size_t ws_size, hipStream_t stream) {
    static int grid = 0;
    if (grid == 0) {
        int dev = 0, cus = 0, per_cu = 0;
        hipGetDevice(&dev);
        hipDeviceGetAttribute(&cus, hipDeviceAttributeMultiprocessorCount, dev);
        hipFuncSetAttribute((const void*)fwd_kernel, hipFuncAttributeMaxDynamicSharedMemorySize, LDS_BYTES);
        hipOccupancyMaxActiveBlocksPerMultiprocessor(&per_cu, (const void*)fwd_kernel, 512, LDS_BYTES);
        (void)hipGetLastError();
        if (per_cu < 1) per_cu = 1;
        grid = cus * 1;
        if (grid <= 0) grid = 256;
        if (ws_size < WS_END) { fprintf(stderr, "workspace too small: %zu < %zu\n", ws_size, (size_t)WS_END); }
    }
    Args a{};
    for (int i = 0; i < 29; ++i) a.in[i] = (const float*)d_in[i];
    a.out = (float*)d_out; a.ws = (unsigned char*)d_ws;
#if ONE_LAUNCH
    a.ph_lo = 0; a.ph_hi = 10; a.coop = 1;
    hipMemsetAsync((unsigned char*)d_ws + WS_BAR, 0, BAR_BYTES, stream);
    void* kargs[] = {&a};
    hipError_t e = hipLaunchCooperativeKernel((const void*)fwd_kernel, dim3(grid), dim3(512), kargs, LDS_BYTES, stream);
    if (e != hipSuccess) fprintf(stderr, "cooperative launch failed: %s (grid %d)\n", hipGetErrorString(e), grid);
#else
    for (int ph = 0; ph < 10; ++ph) {
        a.ph_lo = ph; a.ph_hi = ph + 1; a.coop = 0;
        hipLaunchKernelGGL(fwd_kernel, dim3(grid), dim3(512), LDS_BYTES, stream, a);
    }
#endif
}
```

```cpp
#include <hip/hip_runtime.h>
#include <hip/hip_cooperative_groups.h>
#include <cstdio>
#include <cstdint>
namespace cg = cooperative_groups;

#ifndef ONE_LAUNCH
#define ONE_LAUNCH 1
#endif

#ifndef PROBE_P0
#define PROBE_P0 0
#endif
#ifndef PROBE_BAR
#define PROBE_BAR 0
#endif
#ifndef PROBE_P6
#define PROBE_P6 0
#endif
#ifndef PROBE_X
#define PROBE_X 0
#endif
#ifndef PROBE_P1
#define PROBE_P1 0
#endif
#ifndef REP_MIX
#define REP_MIX 1
#endif
#ifndef PHMASK
#define PHMASK 0x3ff
#endif
#define LAS __attribute__((address_space(3)))
typedef unsigned short bf16_t;
typedef short bf16x8 __attribute__((ext_vector_type(8)));
typedef float f32x4 __attribute__((ext_vector_type(4)));
typedef float f32x16 __attribute__((ext_vector_type(16)));
typedef unsigned u32x4 __attribute__((ext_vector_type(4)));
typedef unsigned u32x2 __attribute__((ext_vector_type(2)));

constexpr int D = 1024, NBATCH = 8, SEQ = 2048, MPR = NBATCH * SEQ, MS = 128, MV = MPR + MS, MP = 65 * 256;
constexpr int NZ = 3072, FF = 4096, PLE = 256, PW = 512;
constexpr float EPS = 1e-6f;
constexpr int NCHUNK = 16, CHUNK = 128;
constexpr size_t O_YP = 0, O_YS = 16777216, O_POOLP = 16908288, O_POOLS = 16969728, O_REP = 17952768, O_IMP = 17969152, O_RES = 17985536, O_IMS = 18247680;
constexpr size_t MiB = 1u << 20;
constexpr size_t WS_SS = 0;
constexpr size_t WS_BAR = 512 * 1024;
constexpr size_t BAR_BYTES = 16384;
constexpr size_t WS_ABAR = 1 * MiB;
constexpr size_t WS_A16 = WS_ABAR + 16384, WS_A128 = WS_A16 + 16384;
constexpr size_t WS_BBFR = WS_A128 + 16384;
constexpr size_t WS_BBFI = WS_BBFR + 131072;
constexpr size_t WS_BBT = WS_BBFI + 131072;
constexpr size_t WS_CT = WS_BBT + 131072;
constexpr size_t WS_EST = 2 * MiB;
constexpr size_t WS_WIN = 4 * MiB, WS_WGLU = 10 * MiB, WS_WOUT = 12 * MiB, WS_WFF1 = 14 * MiB, WS_WFF2 = 22 * MiB;
constexpr size_t WS_WPLE = 30 * MiB, WS_WPOOL = 30 * MiB + 512 * 1024, WS_WPLEG = 31 * MiB;
constexpr size_t WS_PB = 33 * MiB;
constexpr size_t WS_R1 = 42 * MiB;
constexpr size_t WS_R2 = 75 * MiB;
constexpr size_t WS_Z = 108 * MiB;
constexpr size_t WS_POOLED = WS_Z + (size_t)MP * NZ * 2;
constexpr size_t WS_GL = WS_POOLED + (size_t)MP * PW * 2;
constexpr size_t WS_F = WS_Z;
constexpr size_t WS_END = WS_GL + (size_t)MP * PW * 2;
constexpr size_t WS_SSP = 240 * MiB;
constexpr size_t SSP_STRIDE = (size_t)MP * 16;
static_assert(WS_END <= WS_SSP && WS_SSP + 3 * SSP_STRIDE * 4 <= 256 * MiB, "ws map");
static_assert(WS_F + (size_t)MP * FF * 2 <= WS_END, "F overlay");

constexpr int LDS_BYTES = 147456;

__device__ __forceinline__ unsigned f2bf(float f) { unsigned u = __builtin_bit_cast(unsigned, f); return (u + 0x7fffu + ((u >> 16) & 1u)) >> 16; }
typedef float f32x2_t __attribute__((ext_vector_type(2))); typedef __bf16 bf16x2_t __attribute__((ext_vector_type(2)));
__device__ __forceinline__ unsigned pk2(float lo, float hi) { f32x2_t v = {lo, hi}; bf16x2_t b = __builtin_convertvector(v, bf16x2_t); return __builtin_bit_cast(unsigned, b); }
__device__ __forceinline__ float bflo(unsigned w) { return __builtin_bit_cast(float, w << 16); }
__device__ __forceinline__ float bfhi(unsigned w) { return __builtin_bit_cast(float, w & 0xffff0000u); }
__device__ __forceinline__ float sigmoidf_(float x) { return __builtin_amdgcn_rcpf(1.0f + __expf(-x)); }
__device__ __forceinline__ float gelu_tanh(float x) { const float u = 1.5957691216f * (x + 0.044715f * x * x * x); return x * sigmoidf_(u); }
__device__ __forceinline__ float wave_sum(float v) {
#pragma unroll
    for (int o = 1; o < 64; o <<= 1) v += __shfl_xor(v, o);
    return v;
}
#define LDS_WAIT() asm volatile("s_waitcnt lgkmcnt(0)" ::: "memory")
#ifndef WT_STORES
#define WT_STORES 0
#endif
__device__ __forceinline__ void st8(void* p, u32x2 v) {
#if WT_STORES
    __hip_atomic_store((unsigned long long*)p, ((unsigned long long)v.y << 32) | (unsigned long long)v.x, __ATOMIC_RELAXED, __HIP_MEMORY_SCOPE_AGENT);
#else
    *(u32x2*)p = v;
#endif
}
__device__ __forceinline__ float ssp_rstd(const float* ssp, int row) {
    const f32x4* q = (const f32x4*)(ssp + (size_t)row * 16); const f32x4 a = q[0], b = q[1], c = q[2], d = q[3];
    const float t = ((a[0] + a[1]) + (a[2] + a[3])) + ((b[0] + b[1]) + (b[2] + b[3])) + ((c[0] + c[1]) + (c[2] + c[3])) + ((d[0] + d[1]) + (d[2] + d[3]));
    return rsqrtf(t * (1.f / 1024.f) + 1e-6f); }
__device__ __forceinline__ float ssp_rstd4(const float* ssp, int row) {
    const int fq = (threadIdx.x & 63) >> 4;
    const f32x4 a = ((const f32x4*)(ssp + (size_t)row * 16))[fq];
    float t = (a[0] + a[1]) + (a[2] + a[3]);
    t += __shfl_xor(t, 16); t += __shfl_xor(t, 32);
    return rsqrtf(t * (1.f / 1024.f) + 1e-6f); }
__device__ __forceinline__ void ssp_put(float* ssp, int row, int slot, float p) { if (slot >= 0) ssp[(size_t)row * 16 + slot] = p; else atomicAdd(ssp + (size_t)row * 16, p); }

namespace pg8 {
constexpr int BM = 256, BK = 64, HALF = 128, HTB = HALF * BK * 2, STAGE_BYTES = 8 * HTB, NXCD = 8, WGM = 8;
__host__ __device__ __forceinline__ int lds_byte(int r, int c) { const int st = (r >> 4) * 2 + (c >> 5), rr = r & 15, cc = c & 31, ob = rr * 64 + cc * 2; return st * 1024 + (ob ^ (((ob >> 9) & 1) << 5)); }
__host__ __device__ __forceinline__ void stage_rc(int b, int& R, int& C) { const int st = b / 1024, sb = b % 1024, swz = sb ^ (((sb >> 9) & 1) << 5); R = (st >> 1) * 16 + swz / 64; C = (st & 1) * 32 + (swz % 64) / 2; }
struct Unit { int pm, pn; };
struct Gemm { const bf16_t* A; const bf16_t* Bt; int M, N, K, lda, ldb, a_pn_off; };
struct StaticOrder {
    int nM, nN, nwg, G, c;
    __host__ __device__ void init(int M, int N, int G_, int c_) { nM = M / BM; nN = N / BM; nwg = nM * nN; G = G_; c = c_; }
    __host__ __device__ bool next(int i, Unit& u) const {
        const long L = (long)i * G + c; if (L >= nwg) return false;
        int wgid = (int)L; { const int q = nwg / NXCD, r = nwg % NXCD, xcd = wgid % NXCD, off = wgid / NXCD; wgid = (xcd < r ? xcd * (q + 1) : r * (q + 1) + (xcd - r) * q) + off; }
        const int nig = WGM * nN, gid = wgid / nig, fm = gid * WGM, gsz = (nM - fm) < WGM ? (nM - fm) : WGM;
        u.pm = fm + ((wgid % nig) % gsz); u.pn = (wgid % nig) / gsz; return true;
    }
};

template <class F> struct EpiStrip {
    F f;
    __device__ __forceinline__ void operator()(const f32x4 (&acc)[2][2][4][2], const Unit& u, int wr, int wc, int fr, int fq) const {
        asm volatile("" ::: "memory");
        float rs[2][4];
#pragma unroll
        for (int ai = 0; ai < 2; ++ai) {
#pragma unroll
            for (int m = 0; m < 4; ++m) rs[ai][m] = f.rowinit(u.pm * BM + ai * HALF + wr * 64 + m * 16 + fr);
            asm volatile("" ::: "memory");
        }
        typename F::Cd cd[2][2];
#pragma unroll
        for (int bj = 0; bj < 2; ++bj)
#pragma unroll
            for (int n = 0; n < 2; ++n) cd[bj][n] = f.colinit(u.pn * BM + bj * HALF + wc * 32 + n * 16 + 4 * fq);
#pragma unroll
        for (int ai = 0; ai < 2; ++ai)
#pragma unroll
        for (int mp = 0; mp < 4; mp += F::MB) {
            typename F::Ld ld[F::MB][2][2];
#pragma unroll
            for (int mi = 0; mi < F::MB; ++mi)
#pragma unroll
                for (int bj = 0; bj < 2; ++bj)
#pragma unroll
                    for (int n = 0; n < 2; ++n)
                        ld[mi][bj][n] = f.load(u.pm * BM + ai * HALF + wr * 64 + (mp + mi) * 16 + fr, u.pn * BM + bj * HALF + wc * 32 + n * 16 + 4 * fq);
#pragma unroll
            for (int mi = 0; mi < F::MB; ++mi) {
                const int m = mp + mi;
                const int row = u.pm * BM + ai * HALF + wr * 64 + m * 16 + fr;
                float part = 0.f;
#pragma unroll
                for (int bj = 0; bj < 2; ++bj)
#pragma unroll
                    for (int n = 0; n < 2; ++n) {
                        const int col0 = u.pn * BM + bj * HALF + wc * 32 + n * 16 + 4 * fq;
                        part += f.apply(row, col0, acc[ai][bj][m][n], rs[ai][m], ld[mi][bj][n], cd[bj][n]);
                    }
                if (F::ROWSTAT) { part += __shfl_xor(part, 16); part += __shfl_xor(part, 32); if (fq == 0) f.rowdone(row, part, u.pn * 4 + wc); }
            }
            asm volatile("" ::: "memory");
        }
    }
};

template <class Epi, bool ALIGN_EPI>
__device__ __forceinline__ void gemm_phase(LAS unsigned char* lds, const Gemm g, const StaticOrder& S, const Epi& E) {
    const int tid = threadIdx.x, wid = __builtin_amdgcn_readfirstlane(tid >> 6), lane = tid & 63, wr = wid >> 2, wc = wid & 3, fr = lane & 15, fq = lane >> 4;
    const int K = g.K; int nt = K / BK; asm volatile("" : "+s"(nt));
    unsigned voffA[2], voffB[2];
#pragma unroll
    for (int i = 0; i < 2; ++i) { int R, C; stage_rc(tid * 16 + i * 8192, R, C);
        voffA[i] = (unsigned)(R * g.lda + C) * 2u; voffB[i] = (unsigned)(R * g.ldb + C) * 2u; }
    const size_t kstep = (size_t)(BK * 2);
    const size_t hstepA = (size_t)HALF * g.lda * 2, hstepB = (size_t)HALF * g.ldb * 2;
    const size_t tstepA = 2 * hstepA, tstepB = 2 * hstepB;
    const unsigned ldsw = (unsigned)wid * 1024u;
    const int aoff = lds_byte(wr * 64 + fr, fq * 8), boff = lds_byte(wc * 32 + fr, fq * 8);
#define PG8_SA(b, h) (((b) * 2 + (h)) * HTB)
#define PG8_SB(b, h) ((4 + (b) * 2 + (h)) * HTB)
#define PG8_STAGE(bufoff, gbase, voff) do { _Pragma("unroll") for (int _i = 0; _i < 2; ++_i) \
        __builtin_amdgcn_global_load_lds((const unsigned*)((const char*)(gbase) + (voff)[_i]), (LAS unsigned*)(lds + (bufoff) + ldsw + _i * 8192), 16, 0, 0); } while (0)
#define PG8_LDA(dst, b, h) do { _Pragma("unroll") for (int m = 0; m < 4; ++m) _Pragma("unroll") for (int k = 0; k < 2; ++k) dst[m][k] = *(const LAS bf16x8*)(lds + PG8_SA(b, h) + aoff + m * 2048 + k * 1024); } while (0)
#define PG8_LDB(dst, b, h) do { _Pragma("unroll") for (int n = 0; n < 2; ++n) _Pragma("unroll") for (int k = 0; k < 2; ++k) dst[n][k] = *(const LAS bf16x8*)(lds + PG8_SB(b, h) + boff + n * 2048 + k * 1024); } while (0)
#define PG8_MMA(ai, bj, At, Bt) do { __builtin_amdgcn_s_setprio(1); _Pragma("unroll") for (int m = 0; m < 4; ++m) _Pragma("unroll") for (int n = 0; n < 2; ++n) _Pragma("unroll") for (int k = 0; k < 2; ++k) \
        acc[ai][bj][m][n] = __builtin_amdgcn_mfma_f32_16x16x32_bf16(Bt[n][k], At[m][k], acc[ai][bj][m][n], 0, 0, 0); __builtin_amdgcn_s_setprio(0); } while (0)
#define PG8_WAIT_V(n) asm volatile("s_waitcnt vmcnt(" #n ")" ::: "memory")
#define PG8_WAIT_L(n) asm volatile("s_waitcnt lgkmcnt(" #n ")" ::: "memory")
#define PG8_BAR __builtin_amdgcn_s_barrier()
#define PG8_SCHED __builtin_amdgcn_sched_barrier(0)
    Unit cur, nxt; int ui = 0;
    if (!S.next(0, cur)) return;
    f32x4 acc[2][2][4][2];
#pragma unroll
    for (int a = 0; a < 2; ++a)
#pragma unroll
        for (int b = 0; b < 2; ++b)
#pragma unroll
            for (int m = 0; m < 4; ++m)
#pragma unroll
                for (int n = 0; n < 2; ++n) acc[a][b][m][n] = (f32x4){0.f, 0.f, 0.f, 0.f};
    bf16x8 At[4][2], B0[2][2], B1[2][2];
    const char* cA = (const char*)g.A + (size_t)cur.pm * tstepA + (size_t)cur.pn * g.a_pn_off; const char* cB = (const char*)g.Bt + (size_t)cur.pn * tstepB;
    PG8_STAGE(PG8_SB(0, 0), cB, voffB); PG8_STAGE(PG8_SB(0, 1), cB + hstepB, voffB); PG8_STAGE(PG8_SA(0, 0), cA, voffA); PG8_STAGE(PG8_SA(0, 1), cA + hstepA, voffA);
    if (wr == 1) PG8_BAR;
    PG8_WAIT_V(2); PG8_BAR;
    PG8_STAGE(PG8_SB(1, 0), cB + kstep, voffB); PG8_STAGE(PG8_SA(1, 0), cA + kstep, voffA); PG8_STAGE(PG8_SB(1, 1), cB + hstepB + kstep, voffB);
    PG8_WAIT_V(6); PG8_BAR;
    for (;;) {
        const bool has_next = S.next(ui + 1, nxt);
        const char* nA = has_next ? (const char*)g.A + (size_t)nxt.pm * tstepA + (size_t)nxt.pn * g.a_pn_off : cA; const char* nB = has_next ? (const char*)g.Bt + (size_t)nxt.pn * tstepB : cB;
        for (int t = 0; t < nt; t += 2) {
            const bool last = (t == nt - 2);
            const char* a1 = cA + (size_t)(t + 1) * kstep;
            const char* a2 = last ? nA : cA + (size_t)(t + 2) * kstep; const char* b2 = last ? nB : cB + (size_t)(t + 2) * kstep;
            const char* a3 = a2 + kstep; const char* b3 = b2 + kstep;
            PG8_LDB(B0, 0, 0); PG8_LDB(B1, 0, 1); PG8_SCHED; PG8_LDA(At, 0, 0); PG8_STAGE(PG8_SA(1, 1), a1 + hstepA, voffA);
            PG8_WAIT_V(8); PG8_WAIT_L(0); PG8_BAR; PG8_MMA(0, 0, At, B0); PG8_MMA(0, 1, At, B1); PG8_BAR; PG8_SCHED;
            PG8_LDA(At, 0, 1); PG8_STAGE(PG8_SB(0, 0), b2, voffB); PG8_STAGE(PG8_SB(0, 1), b2 + hstepB, voffB); PG8_STAGE(PG8_SA(0, 0), a2, voffA);
            PG8_WAIT_V(8); PG8_WAIT_L(0); PG8_BAR; PG8_MMA(1, 0, At, B0); PG8_MMA(1, 1, At, B1); PG8_BAR; PG8_SCHED;
            PG8_LDB(B0, 1, 0); PG8_LDB(B1, 1, 1); PG8_SCHED; PG8_LDA(At, 1, 0); PG8_STAGE(PG8_SA(0, 1), a2 + hstepA, voffA);
            PG8_WAIT_V(8); PG8_WAIT_L(0); PG8_BAR; PG8_MMA(0, 0, At, B0); PG8_MMA(0, 1, At, B1); PG8_BAR; PG8_SCHED;
            PG8_LDA(At, 1, 1); PG8_STAGE(PG8_SB(1, 0), b3, voffB); PG8_STAGE(PG8_SB(1, 1), b3 + hstepB, voffB); PG8_STAGE(PG8_SA(1, 0), a3, voffA);
            PG8_WAIT_V(8); PG8_WAIT_L(0); PG8_BAR; PG8_MMA(1, 0, At, B0); PG8_MMA(1, 1, At, B1); PG8_BAR; PG8_SCHED;
        }
        if constexpr (ALIGN_EPI) { if (wr == 0) PG8_BAR; }
        E(acc, cur, wr, wc, fr, fq);
        if (!has_next) break;
#pragma unroll
        for (int a = 0; a < 2; ++a)
#pragma unroll
            for (int b = 0; b < 2; ++b)
#pragma unroll
                for (int m = 0; m < 4; ++m)
#pragma unroll
                    for (int n = 0; n < 2; ++n) acc[a][b][m][n] = (f32x4){0.f, 0.f, 0.f, 0.f};
        cur = nxt; cA = nA; cB = nB; ++ui;
        if constexpr (ALIGN_EPI) { if (wr == 1) PG8_BAR; }
    }
    PG8_WAIT_V(0);
    if constexpr (!ALIGN_EPI) { if (wr == 0) PG8_BAR; }
    PG8_BAR;
#undef PG8_SA
#undef PG8_SB
#undef PG8_STAGE
#undef PG8_LDA
#undef PG8_LDB
#undef PG8_MMA
#undef PG8_WAIT_V
#undef PG8_WAIT_L
#undef PG8_BAR
#undef PG8_SCHED
}
}

#define XB_TMO      128
#define XB_XCNT(j)  (256  + 64 * (j))
#define XB_XSUB(j)  (1280 + 64 * (j))
#define XB_XGEN(j)  (2304 + 64 * (j))
#define XB_TOP      3328
#define XB_TOPGEN   3392
#define XCD_BAR_WORDS 3456
#define XB_SPIN_CAP (1u << 18)
__device__ __forceinline__ unsigned xb_ld(unsigned* p)              { return __hip_atomic_load(p, __ATOMIC_RELAXED, __HIP_MEMORY_SCOPE_AGENT); }
__device__ __forceinline__ unsigned xb_add(unsigned* p, unsigned v) { return __hip_atomic_fetch_add(p, v, __ATOMIC_RELAXED, __HIP_MEMORY_SCOPE_AGENT); }
__device__ __forceinline__ unsigned xb_xcc_id() { return (unsigned)__builtin_amdgcn_s_getreg((3 << 11) | 20) & 0xFu; }
#define XB_SPIN(cond, bar) do { unsigned _sp = 0; while (cond) { __builtin_amdgcn_s_sleep(1); \
    if ((++_sp & 255u) == 0u) { if (xb_ld(&(bar)[XB_TMO])) break; if (_sp > XB_SPIN_CAP) { atomicAdd(&(bar)[XB_TMO], 1u); break; } } } } while (0)
struct XcdBarrier { unsigned* bar; unsigned x; volatile LAS unsigned* st; };
__device__ __forceinline__ XcdBarrier xcd_barrier_post(unsigned* bar, volatile LAS unsigned* st) {
    XcdBarrier b; b.bar = bar; b.x = xb_xcc_id(); b.st = st;
    if (threadIdx.x == 0) (void)xb_add(&bar[XB_XCNT(b.x)], 1u);
    return b;
}
__device__ __forceinline__ void xcd_barrier_complete(unsigned* bar, unsigned x, unsigned& nloc, unsigned& nx) {
    const unsigned G = gridDim.x * gridDim.y * gridDim.z;
    unsigned sum, cnt, mine, sp = 0u;
    for (;;) {
        sum = 0u; cnt = 0u; mine = 0u;
#pragma unroll
        for (unsigned j = 0; j < 16; ++j) { const unsigned c = xb_ld(&bar[XB_XCNT(j)]); sum += c; cnt += (c > 0u) ? 1u : 0u; mine = (j == x) ? c : mine; }
        if (sum == G) break;
        __builtin_amdgcn_s_sleep(1);
        if ((++sp & 255u) == 0u) { if (xb_ld(&bar[XB_TMO])) break; if (sp > XB_SPIN_CAP) { atomicAdd(&bar[XB_TMO], 1u); break; } }
    }
    nloc = mine > 0u ? mine : 1u; nx = cnt > 0u ? cnt : 1u;
}
__device__ __forceinline__ void xcd_barrier(const XcdBarrier& b) {
    asm volatile("s_waitcnt vmcnt(0)" ::: "memory");
    __syncthreads();
    if (threadIdx.x == 0) {
        unsigned* bar = b.bar;
        __builtin_amdgcn_s_waitcnt(0);
        unsigned nloc = b.st[0], nx = b.st[1];
        if (nloc == 0u) { xcd_barrier_complete(bar, b.x, nloc, nx); b.st[0] = nloc; b.st[1] = nx; }
        const unsigned old = xb_add(&bar[XB_XSUB(b.x)], 1u);
        const unsigned gen = old / nloc;
        if (old + 1u == (gen + 1u) * nloc) {
            __builtin_amdgcn_fence(__ATOMIC_RELEASE, "agent");
            asm volatile("s_waitcnt vmcnt(0)" ::: "memory");
            const unsigned og = xb_add(&bar[XB_TOP], 1u);
            const unsigned tg = og / nx;
            if (og + 1u == (tg + 1u) * nx) xb_add(&bar[XB_TOPGEN], 1u);
            else XB_SPIN(xb_ld(&bar[XB_TOPGEN]) == tg, bar);
            __builtin_amdgcn_fence(__ATOMIC_ACQUIRE, "agent");
            xb_add(&bar[XB_XGEN(b.x)], 1u);
            asm volatile("s_waitcnt vmcnt(0)" ::: "memory");
        } else {
            XB_SPIN(xb_ld(&bar[XB_XGEN(b.x)]) == gen, bar);
            __builtin_amdgcn_fence(__ATOMIC_ACQUIRE, "agent");
            asm volatile("s_waitcnt vmcnt(0)" ::: "memory");
        }
    }
    __syncthreads();
}

struct Args { const float* in[29]; float* out; unsigned char* ws; int ph_lo, ph_hi, coop, pad; };

struct Frame {
    LAS unsigned char* lds;
    int tid, lane, wave, G, gw, NGW;
    const float* const* in; float* out; unsigned char* ws;
};

struct NoLd {};
struct FZ {
    static constexpr bool ROWSTAT = false; static constexpr int MB = 4; typedef NoLd Ld; typedef NoLd Cd;
    bf16_t* Z; const float* ss;
    __device__ __forceinline__ float rowinit(int row) const { return rsqrtf(ss[row] * (1.f / D) + EPS); }
    __device__ __forceinline__ Cd colinit(int) const { return Cd{}; }
    __device__ __forceinline__ Ld load(int, int) const { return Ld{}; }
    __device__ __forceinline__ float apply(int row, int col, f32x4 v, float rs, Ld, Cd) const {
        u32x2 o; o.x = pk2(v[0] * rs, v[1] * rs); o.y = pk2(v[2] * rs, v[3] * rs);
        st8(Z + (size_t)row * NZ + col, o); return 0.f; }
    __device__ __forceinline__ void rowdone(int, float, int) const {}
};
struct FPool {
    static constexpr bool ROWSTAT = false; static constexpr int MB = 4; struct Ld { u32x2 gz; }; struct Cd { f32x4 ps; };
    bf16_t* TMP; const bf16_t* Z; const float* pscale;
    __device__ __forceinline__ float rowinit(int) const { return 0.f; }
    __device__ __forceinline__ Cd colinit(int col) const { Cd c; c.ps = *(const f32x4*)(pscale + col); return c; }
    __device__ __forceinline__ Ld load(int row, int col) const { Ld l; l.gz = *(const u32x2*)(Z + (size_t)row * NZ + 1024 + col); return l; }
    __device__ __forceinline__ float apply(int row, int col, f32x4 v, float, Ld l, Cd c) const {
        u32x2 o; o.x = pk2(v[0] * c.ps[0] * sigmoidf_(bflo(l.gz.x)), v[1] * c.ps[1] * sigmoidf_(bfhi(l.gz.x)));
        o.y = pk2(v[2] * c.ps[2] * sigmoidf_(bflo(l.gz.y)), v[3] * c.ps[3] * sigmoidf_(bfhi(l.gz.y)));
        st8(TMP + (size_t)row * D + col, o); return 0.f; }
    __device__ __forceinline__ void rowdone(int, float, int) const {}
};
struct FGlu {
    static constexpr bool ROWSTAT = false; static constexpr int MB = 4; struct Ld { unsigned t, gb; }; typedef NoLd Cd;
    bf16_t* MG; const bf16_t* TMP; const bf16_t* Z;
    __device__ __forceinline__ float rowinit(int) const { return 0.f; }
    __device__ __forceinline__ Cd colinit(int) const { return Cd{}; }
    __device__ __forceinline__ Ld load(int row, int col) const { const int j = col >> 1; Ld l; l.t = *(const unsigned*)(TMP + (size_t)row * D + j); l.gb = *(const unsigned*)(Z + (size_t)row * NZ + 2048 + j); return l; }
    __device__ __forceinline__ float apply(int row, int col, f32x4 v, float, Ld l, Cd) const {
        const int j = col >> 1;
        const float m0 = bflo(l.t) + sigmoidf_(bflo(l.gb)) * v[0] * sigmoidf_(v[1]);
        const float m1 = bfhi(l.t) + sigmoidf_(bfhi(l.gb)) * v[2] * sigmoidf_(v[3]);
        *(unsigned*)(MG + (size_t)row * D + j) = pk2(m0, m1); return 0.f; }
    __device__ __forceinline__ void rowdone(int, float, int) const {}
};
struct FOut {
    static constexpr bool ROWSTAT = true; static constexpr int MB = 2; struct Ld { f32x4 x; }; typedef NoLd Cd;
    const float* xp; const float* xs; bf16_t* XB; float* ss;
    __device__ __forceinline__ float rowinit(int) const { return 0.f; }
    __device__ __forceinline__ Cd colinit(int) const { return Cd{}; }
    __device__ __forceinline__ Ld load(int row, int col) const { Ld l; l.x = (row < MPR) ? *(const f32x4*)(xp + (size_t)row * D + col) : *(const f32x4*)(xs + (size_t)(row - MPR) * D + col); return l; }
    __device__ __forceinline__ float apply(int row, int col, f32x4 v, float, Ld l, Cd) const {
        const f32x4 x = l.x + v;
        u32x2 o; o.x = pk2(x[0], x[1]); o.y = pk2(x[2], x[3]); st8(XB + (size_t)row * D + col, o);
        return (x[0] * x[0] + x[1] * x[1]) + (x[2] * x[2] + x[3] * x[3]); }
    __device__ __forceinline__ void rowdone(int row, float p, int slot) const { ssp_put(ss, row, slot, p); }
};
struct FFf1 {
    static constexpr bool ROWSTAT = false; static constexpr int MB = 4; typedef NoLd Ld; typedef NoLd Cd;
    bf16_t* F; const float* ss;
    __device__ __forceinline__ float rowinit(int row) const { return ssp_rstd4(ss, row); }
    __device__ __forceinline__ Cd colinit(int) const { return Cd{}; }
    __device__ __forceinline__ Ld load(int, int) const { return Ld{}; }
    __device__ __forceinline__ float apply(int row, int col, f32x4 v, float rs, Ld, Cd) const {
        float a = fmaxf(v[0] * rs, 0.f), b = fmaxf(v[1] * rs, 0.f), c = fmaxf(v[2] * rs, 0.f), d = fmaxf(v[3] * rs, 0.f);
        u32x2 o; o.x = pk2(a * a, b * b); o.y = pk2(c * c, d * d);
        st8(F + (size_t)row * FF + col, o); return 0.f; }
    __device__ __forceinline__ void rowdone(int, float, int) const {}
};
struct FPle {
    static constexpr bool ROWSTAT = false; static constexpr int MB = 4; typedef NoLd Ld; typedef NoLd Cd;
    bf16_t* PL;
    __device__ __forceinline__ float rowinit(int) const { return 0.f; }
    __device__ __forceinline__ Cd colinit(int) const { return Cd{}; }
    __device__ __forceinline__ Ld load(int, int) const { return Ld{}; }
    __device__ __forceinline__ float apply(int row, int col, f32x4 v, float, Ld, Cd) const {
        u32x2 o; o.x = pk2(v[0], v[1]); o.y = pk2(v[2], v[3]); st8(PL + (size_t)row * D + col, o); return 0.f; }
    __device__ __forceinline__ void rowdone(int, float, int) const {}
};
struct FFf2 {
    static constexpr bool ROWSTAT = true; static constexpr int MB = 4; struct Ld { u32x2 r; }; typedef NoLd Cd;
    bf16_t* XB; float* ss;
    __device__ __forceinline__ float rowinit(int) const { return 0.f; }
    __device__ __forceinline__ Cd colinit(int) const { return Cd{}; }
    __device__ __forceinline__ Ld load(int row, int col) const { Ld l; l.r = *(const u32x2*)(XB + (size_t)row * D + col); return l; }
    __device__ __forceinline__ float apply(int row, int col, f32x4 v, float, Ld l, Cd) const {
        f32x4 x; x[0] = bflo(l.r.x) + v[0]; x[1] = bfhi(l.r.x) + v[1]; x[2] = bflo(l.r.y) + v[2]; x[3] = bfhi(l.r.y) + v[3];
        u32x2 o; o.x = pk2(x[0], x[1]); o.y = pk2(x[2], x[3]); st8(XB + (size_t)row * D + col, o);
        return (x[0] * x[0] + x[1] * x[1]) + (x[2] * x[2] + x[3] * x[3]); }
    __device__ __forceinline__ void rowdone(int row, float p, int slot) const { ssp_put(ss, row, slot, p); }
};
struct FPleg {
    static constexpr bool ROWSTAT = true; static constexpr int MB = 2; struct Ld { u32x2 r, pl; }; typedef NoLd Cd;
    const bf16_t* XB; bf16_t* X3; const bf16_t* PL; const float* ss2; float* ss3;
    __device__ __forceinline__ float rowinit(int row) const { return ssp_rstd4(ss2, row); }
    __device__ __forceinline__ Cd colinit(int) const { return Cd{}; }
    __device__ __forceinline__ Ld load(int row, int col) const { Ld l; l.r = *(const u32x2*)(XB + (size_t)row * D + col); l.pl = *(const u32x2*)(PL + (size_t)row * D + col); return l; }
    __device__ __forceinline__ float apply(int row, int col, f32x4 v, float rs, Ld l, Cd) const {
        f32x4 x;
        x[0] = bflo(l.r.x) + bflo(l.pl.x) * sigmoidf_(v[0] * rs); x[1] = bfhi(l.r.x) + bfhi(l.pl.x) * sigmoidf_(v[1] * rs);
        x[2] = bflo(l.r.y) + bflo(l.pl.y) * sigmoidf_(v[2] * rs); x[3] = bfhi(l.r.y) + bfhi(l.pl.y) * sigmoidf_(v[3] * rs);
        u32x2 o; o.x = pk2(x[0], x[1]); o.y = pk2(x[2], x[3]); st8(X3 + (size_t)row * D + col, o);
        return (x[0] * x[0] + x[1] * x[1]) + (x[2] * x[2] + x[3] * x[3]); }
    __device__ __forceinline__ void rowdone(int row, float p, int slot) const { ssp_put(ss3, row, slot, p); }
};

template <class FN, int NT, int K, int N>
__device__ __forceinline__ void sgemm_phase(const Frame& Fr, const FN& f, const bf16_t* A, int lda, int a_grp_off, const bf16_t* Bt, int ldb) {
    const int lane = Fr.lane, fr = lane & 15, fq = lane >> 4, w = Fr.wave;
    constexpr int nslab = N / (16 * NT), nitems = 8 * nslab;
    constexpr int KPER = K >= 256 ? K / 8 : 32, KS = KPER / 32;
    constexpr int UBR = 36 / (1 + NT), UB0 = KS < 8 ? KS : 8, UB = UB0 < UBR ? UB0 : UBR;
    static_assert(KS % UB == 0, "sgemm unroll");
    LAS float* red = (LAS float*)Fr.lds;
    for (int it = blockIdx.x; it < nitems; it += Fr.G) {
        const int rt = it & 7, cs = it >> 3;
        const int col_base = cs * 16 * NT;
        const int akoff = (col_base >> 8) * a_grp_off;
        f32x4 acc[NT];
#pragma unroll
        for (int n = 0; n < NT; ++n) acc[n] = (f32x4){0.f, 0.f, 0.f, 0.f};
        const int k0 = w * KPER;
        if (k0 < K) {
            const bf16_t* ap = A + (size_t)(MPR + rt * 16 + fr) * lda + akoff + k0 + 8 * fq;
            const bf16_t* bp = Bt + (size_t)(col_base + fr) * ldb + k0 + 8 * fq;
#pragma unroll
            for (int kb = 0; kb < KS; kb += UB) {
                bf16x8 af[UB], bfr[UB][NT];
#pragma unroll
                for (int u = 0; u < UB; ++u) {
                    af[u] = *(const bf16x8*)(ap + (kb + u) * 32);
#pragma unroll
                    for (int n = 0; n < NT; ++n) bfr[u][n] = *(const bf16x8*)(bp + (size_t)n * 16 * ldb + (kb + u) * 32);
                }
#pragma unroll
                for (int u = 0; u < UB; ++u)
#pragma unroll
                    for (int n = 0; n < NT; ++n) acc[n] = __builtin_amdgcn_mfma_f32_16x16x32_bf16(bfr[u][n], af[u], acc[n], 0, 0, 0);
            }
        }
#pragma unroll
        for (int n = 0; n < NT; ++n) *(LAS f32x4*)(red + ((w * NT + n) * 64 + lane) * 4) = acc[n];
        __syncthreads();
        for (int n = w; n < NT; n += 8) {
            f32x4 sum = (f32x4){0.f, 0.f, 0.f, 0.f};
#pragma unroll
            for (int ww = 0; ww < 8; ++ww) sum = sum + *(const LAS f32x4*)(red + ((ww * NT + n) * 64 + lane) * 4);
            const int row = MPR + rt * 16 + fr, col0 = col_base + n * 16 + 4 * fq;
            const float rs = f.rowinit(row);
            const typename FN::Ld ld = f.load(row, col0); const typename FN::Cd cd = f.colinit(col0);
            float part = f.apply(row, col0, sum, rs, ld, cd);
            if (FN::ROWSTAT) { part += __shfl_xor(part, 16); part += __shfl_xor(part, 32); if (fq == 0) f.rowdone(row, part, -1); }
        }
        __syncthreads();
    }
}

struct TItem { const float* W; const float* gain; bf16_t* WT; int K, N, row_mul, row_off, k0, n0; };
__device__ __forceinline__ void p0_tload(const TItem& t, int lane, float (&w)[32]) {
#pragma unroll
    for (int i = 0; i < 32; ++i) { const int kk = 2 * i + (lane >> 5); float v = t.W[(size_t)(t.k0 + kk) * t.N + t.n0 + (lane & 31)]; if (t.gain) v *= t.gain[t.k0 + kk]; w[i] = v; }
}
__device__ __forceinline__ void p0_tstore(const TItem& t, int lane, LAS float* scr, const float (&w)[32]) {
#pragma unroll
    for (int i = 0; i < 32; ++i) { const int kk = 2 * i + (lane >> 5); scr[kk * 33 + (lane & 31)] = w[i]; }
    LDS_WAIT();
    const int c = lane & 7;
#pragma unroll
    for (int j = 0; j < 4; ++j) { const int n = (lane >> 3) + 8 * j; const LAS float* sp = scr + (8 * c) * 33 + n;
        u32x4 o; o.x = pk2(sp[0 * 33], sp[1 * 33]); o.y = pk2(sp[2 * 33], sp[3 * 33]); o.z = pk2(sp[4 * 33], sp[5 * 33]); o.w = pk2(sp[6 * 33], sp[7 * 33]);
        *(u32x4*)(t.WT + (size_t)(t.row_off + (t.n0 + n) * t.row_mul) * t.K + t.k0 + 8 * c) = o; }
    LDS_WAIT();
}
__device__ __forceinline__ TItem p0_mk(const float* W, int K, int N, bf16_t* WT, int row_mul, int row_off, const float* gain, int item) {
    const int nblk = N / 32; TItem t; t.W = W; t.gain = gain; t.WT = WT; t.K = K; t.N = N; t.row_mul = row_mul; t.row_off = row_off; t.k0 = 64 * (item / nblk); t.n0 = 32 * (item % nblk); return t;
}
__device__ __forceinline__ TItem p0_decode(const Frame& F, int it) {
    unsigned char* ws = F.ws;
    constexpr int I_IN = 16 * 96, I_GV = 8 * 32, I_OUT = 16 * 32, I_F1 = 16 * 128, I_F2 = 64 * 32, I_PLE = 4 * 32, I_PG = 16 * 32, I_POOL = 2 * 8;
    int r = it;
    if (r < I_IN) return p0_mk(F.in[8], D, NZ, (bf16_t*)(ws + WS_WIN), 1, 0, F.in[7], r); r -= I_IN;
    if (r < I_GV) return p0_mk(F.in[19], PW, D, (bf16_t*)(ws + WS_WGLU), 2, 0, nullptr, r); r -= I_GV;
    if (r < I_GV) return p0_mk(F.in[20], PW, D, (bf16_t*)(ws + WS_WGLU), 2, 1, nullptr, r); r -= I_GV;
    if (r < I_OUT) return p0_mk(F.in[21], D, D, (bf16_t*)(ws + WS_WOUT), 1, 0, nullptr, r); r -= I_OUT;
    if (r < I_F1) return p0_mk(F.in[23], D, FF, (bf16_t*)(ws + WS_WFF1), 1, 0, F.in[22], r); r -= I_F1;
    if (r < I_F2) return p0_mk(F.in[24], FF, D, (bf16_t*)(ws + WS_WFF2), 1, 0, nullptr, r); r -= I_F2;
    if (r < I_PLE) return p0_mk(F.in[26], PLE, D, (bf16_t*)(ws + WS_WPLE), 1, 0, nullptr, r); r -= I_PLE;
    if (r < I_PG) return p0_mk(F.in[27], D, D, (bf16_t*)(ws + WS_WPLEG), 1, 0, F.in[25], r); r -= I_PG;
    const int g = r / I_POOL, rr = r % I_POOL;
    return p0_mk(F.in[9] + (size_t)g * 128 * 256, 128, 256, (bf16_t*)(ws + WS_WPOOL), 1, g * 256, nullptr, rr);
}

__device__ __forceinline__ void p0_prologue(const Frame& F) {
    LAS float* scr = (LAS float*)(F.lds + F.wave * 16384);
    unsigned char* ws = F.ws;
    constexpr int NITEMS = 16 * 96 + 2 * 8 * 32 + 16 * 32 + 16 * 128 + 64 * 32 + 4 * 32 + 16 * 32 + 4 * 2 * 8;
    {
        int it = F.gw; float w0[32], w1[32]; TItem t0, t1;
        if (it < NITEMS) { t0 = p0_decode(F, it); p0_tload(t0, F.lane, w0); }
        while (it < NITEMS) {
            const int itn = it + F.NGW;
            if (itn < NITEMS) { t1 = p0_decode(F, itn); p0_tload(t1, F.lane, w1); }
            p0_tstore(t0, F.lane, scr, w0);
            t0 = t1;
#pragma unroll
            for (int i = 0; i < 32; ++i) w0[i] = w1[i];
            it = itn;
        }
    }
    float* ss0 = (float*)(ws + WS_SS);
    bf16_t* XB = (bf16_t*)(ws + WS_R1); bf16_t* PB = (bf16_t*)(ws + WS_PB);
    for (int m0 = F.gw; m0 < MV; m0 += 2 * F.NGW) {
        f32x4 v[2][4], pv[2];
#pragma unroll
        for (int q = 0; q < 2; ++q) {
            const int m = m0 + q * F.NGW;
            if (m < MV) {
                const float* xrow = (m < MPR) ? F.in[0] + (size_t)m * D : F.in[1] + (size_t)(m - MPR) * D;
                const f32x4* xr = (const f32x4*)xrow + F.lane;
#pragma unroll
                for (int j = 0; j < 4; ++j) v[q][j] = xr[64 * j];
                const float* prow = (m < MPR) ? F.in[2] + (size_t)m * PLE : F.in[3] + (size_t)(m - MPR) * PLE;
                pv[q] = ((const f32x4*)prow)[F.lane];
            }
        }
#pragma unroll
        for (int q = 0; q < 2; ++q) {
            const int m = m0 + q * F.NGW;
            if (m < MV) {
                float sq = 0.f;
#pragma unroll
                for (int j = 0; j < 4; ++j) sq += (v[q][j][0] * v[q][j][0] + v[q][j][1] * v[q][j][1]) + (v[q][j][2] * v[q][j][2] + v[q][j][3] * v[q][j][3]);
                sq = wave_sum(sq);
                if (F.lane == 0) ss0[m] = sq;
                u32x2* o8 = (u32x2*)(XB + (size_t)m * D) + F.lane;
#pragma unroll
                for (int j = 0; j < 4; ++j) { u32x2 o; o.x = pk2(v[q][j][0], v[q][j][1]); o.y = pk2(v[q][j][2], v[q][j][3]); o8[64 * j] = o; }
                u32x2 po; po.x = pk2(pv[q][0], pv[q][1]); po.y = pk2(pv[q][2], pv[q][3]);
                ((u32x2*)(PB + (size_t)m * PLE))[F.lane] = po;
            }
        }
    }
    const int gt = blockIdx.x * 512 + F.tid, NGT = F.G * 512;
    { float* ssp = (float*)(ws + WS_SSP); for (int i = gt; i < 3 * MS * 16; i += NGT) { const int a = i / (MS * 16), r = i % (MS * 16); ssp[a * SSP_STRIDE + (size_t)MPR * 16 + r] = 0.f; } }
    for (int i = MV + gt; i < MP; i += NGT) ss0[i] = 1.f;
    for (int i = gt; i < 2048; i += NGT) {
        const int g = i >> 6, p = i & 63;
        const double dt = exp((double)F.in[13][g]), lr = F.in[11][i], li = F.in[12][i];
        const double mag = exp(lr * dt), ang = li * dt, ar = mag * cos(ang), ai = mag * sin(ang);
        const double den = lr * lr + li * li, nr = ar - 1.0, ni = ai;
        const double kr = (nr * lr + ni * li) / den, ki = (ni * lr - nr * li) / den;
        ((float2*)(ws + WS_ABAR))[i] = make_float2((float)ar, (float)ai);
        double pr = ar, pi = ai;
#pragma unroll 1
        for (int s = 0; s < 7; ++s) { const double tr = pr * pr - pi * pi, ti = 2.0 * pr * pi; pr = tr; pi = ti;
            if (s == 3) ((float2*)(ws + WS_A16))[i] = make_float2((float)pr, (float)pi); }
        ((float2*)(ws + WS_A128))[i] = make_float2((float)pr, (float)pi);
        bf16_t* BBT = (bf16_t*)(ws + WS_BBT); bf16_t* CT = (bf16_t*)(ws + WS_CT);
        float* bbfr = (float*)(ws + WS_BBFR); float* bbfi = (float*)(ws + WS_BBFI);
        for (int h = 0; h < 16; ++h) {
            const double br = F.in[14][(size_t)i * 16 + h], bi = F.in[15][(size_t)i * 16 + h];
            const float bbr = (float)(kr * br - ki * bi), bbi = (float)(kr * bi + ki * br);
            bbfr[(size_t)i * 16 + h] = bbr; bbfi[(size_t)i * 16 + h] = bbi;
            BBT[((size_t)g * 128 + (p & 1) * 32 + (p >> 1)) * 16 + h] = (bf16_t)f2bf(bbr);
            BBT[((size_t)g * 128 + (2 + (p & 1)) * 32 + (p >> 1)) * 16 + h] = (bf16_t)f2bf(bbi);
            CT[((size_t)g * 16 + h) * 128 + 4 * (p >> 1) + (p & 1)] = (bf16_t)f2bf(F.in[16][((size_t)g * 16 + h) * 64 + p]);
            CT[((size_t)g * 16 + h) * 128 + 4 * (p >> 1) + 2 + (p & 1)] = (bf16_t)f2bf(-F.in[17][((size_t)g * 16 + h) * 64 + p]);
        }
    }
}

template <int W>
__device__ __forceinline__ void pool_item(const bf16_t* Z, bf16_t* POOLED, int row0, int t0, int grp, int lane) {
    float xa[15 + W], xb[15 + W];
    const int cofs = grp * 128 + 2 * lane;
#pragma unroll
    for (int i = 0; i < 15 + W; ++i) {
        const int dt = i - (W - 1);
        unsigned w = 0u;
        if (t0 + dt >= 0) w = *(const unsigned*)(Z + (size_t)(row0 + dt) * NZ + cofs);
        xa[i] = bflo(w); xb[i] = bfhi(w);
    }
#pragma unroll
    for (int o = 0; o < 16; ++o) {
        float sa = 0.f, sb = 0.f;
#pragma unroll
        for (int j = 0; j < W; ++j) { sa += xa[o + W - 1 - j]; sb += xb[o + W - 1 - j]; }
        const int t = t0 + o; const float inv = 1.0f / (float)((t + 1 < W) ? (t + 1) : W);
        const float ra = sa * inv - xa[o + W - 1], rb = sb * inv - xb[o + W - 1];
        *(unsigned*)(POOLED + (size_t)(row0 + o) * PW + cofs) = pk2(ra, rb);
    }
}

__device__ __forceinline__ float2 cmul(float2 a, float2 b) { return make_float2(a.x * b.x - a.y * b.y, a.x * b.y + a.y * b.x); }
__device__ __forceinline__ float2 cfma(float2 a, float2 h, float2 b) { return make_float2(a.x * h.x - a.y * h.y + b.x, a.x * h.y + a.y * h.x + b.y); }
__device__ __forceinline__ float2 shfl2(float2 v, int src) { return make_float2(__shfl(v.x, src), __shfl(v.y, src)); }

template <int PASS>
__device__ __forceinline__ void scan_item(const Frame& F, int item, LAS unsigned char* wlds) {
    unsigned char* ws = F.ws;
    const int lane = F.lane, n = lane & 31, hh = lane >> 5;
    const int g = item & 31, c = (item >> 5) & 15, b = item >> 9;
    const bf16_t* Z = (const bf16_t*)(ws + WS_Z);
    const bf16_t* BBT = (const bf16_t*)(ws + WS_BBT);
    const float2* ABAR = (const float2*)(ws + WS_ABAR); const float2* A16 = (const float2*)(ws + WS_A16); const float2* A128 = (const float2*)(ws + WS_A128);
    float2* EST = (float2*)(ws + WS_EST);
    const float2 a0 = ABAR[g * 64 + 2 * n], a1 = ABAR[g * 64 + 2 * n + 1];
    const float2 p0 = A16[g * 64 + 2 * n], p1 = A16[g * 64 + 2 * n + 1];
    bf16x8 bfrag[4];
#pragma unroll
    for (int q = 0; q < 4; ++q) bfrag[q] = *(const bf16x8*)(BBT + ((size_t)g * 128 + q * 32 + n) * 16 + 8 * hh);
    float2 H0 = make_float2(0.f, 0.f), H1 = make_float2(0.f, 0.f);
    if (PASS == 2) {
        const float2 q0 = A128[g * 64 + 2 * n], q1 = A128[g * 64 + 2 * n + 1];
        float2 ev0[NCHUNK - 1], ev1[NCHUNK - 1];
#pragma unroll
        for (int cc = 0; cc < NCHUNK - 1; ++cc) {
            const int ci = cc < c ? cc : 0;
            const float2* e = EST + (((size_t)b * NCHUNK + ci) * 32 + g) * 64 + 2 * n;
            ev0[cc] = e[0]; ev1[cc] = e[1];
        }
#pragma unroll
        for (int cc = 0; cc < NCHUNK - 1; ++cc) if (cc < c) { H0 = cfma(q0, H0, ev0[cc]); H1 = cfma(q1, H1, ev1[cc]); }
    }
    const int tau = 16 * ((n >> 2) & 1) + 4 * (n >> 3) + (n & 3);
    const size_t rowbase = (size_t)b * SEQ + (size_t)c * CHUNK;
#pragma unroll 1
    for (int tt = 0; tt < 4; ++tt) {
        const size_t trow = rowbase + tt * 32;
        const bf16x8 afrag = *(const bf16x8*)(Z + (trow + tau) * NZ + 512 + g * 16 + 8 * hh);
        f32x16 acc[4];
#pragma unroll
        for (int q = 0; q < 4; ++q) {
#pragma unroll
            for (int r = 0; r < 16; ++r) acc[q][r] = 0.f;
            acc[q] = __builtin_amdgcn_mfma_f32_32x32x16_bf16(afrag, bfrag[q], acc[q], 0, 0, 0);
        }
        float2 e0 = make_float2(0.f, 0.f), e1 = make_float2(0.f, 0.f);
#pragma unroll
        for (int r = 0; r < 16; ++r) { e0 = cfma(a0, e0, make_float2(acc[0][r], acc[2][r])); e1 = cfma(a1, e1, make_float2(acc[1][r], acc[3][r])); }
        const float2 lo0 = shfl2(e0, n), lo1 = shfl2(e1, n), hi0 = shfl2(e0, n + 32), hi1 = shfl2(e1, n + 32);
        const float2 m0 = cfma(p0, H0, lo0), m1 = cfma(p1, H1, lo1);
        if (PASS == 2) {
            float2 k0 = hh ? m0 : H0, k1 = hh ? m1 : H1;
#pragma unroll
            for (int r = 0; r < 16; ++r) {
                k0 = cfma(a0, k0, make_float2(acc[0][r], acc[2][r])); k1 = cfma(a1, k1, make_float2(acc[1][r], acc[3][r]));
                u32x2 o; o.x = pk2(k0.x, k1.x); o.y = pk2(k0.y, k1.y);
                *(LAS u32x2*)(wlds + (16 * hh + r) * 272 + 8 * n) = o;
            }
        }
        H0 = cfma(p0, m0, hi0); H1 = cfma(p1, m1, hi1);
        if (PASS == 2) {
            LDS_WAIT();
            const bf16_t* CT = (const bf16_t*)(ws + WS_CT);
            const int fr = lane & 15, fq = lane >> 4;
            bf16x8 cf[4];
#pragma unroll
            for (int ks = 0; ks < 4; ++ks) cf[ks] = *(const bf16x8*)(CT + ((size_t)g * 16 + fr) * 128 + 32 * ks + 8 * fq);
            const f32x4 dsk = *(const f32x4*)(F.in[18] + g * 16 + 4 * fq);
            bf16_t* GL = (bf16_t*)(ws + WS_GL);
#pragma unroll
            for (int m = 0; m < 2; ++m) {
                f32x4 y = (f32x4){0.f, 0.f, 0.f, 0.f};
#pragma unroll
                for (int ks = 0; ks < 4; ++ks) {
                    const bf16x8 hf = *(const LAS bf16x8*)(wlds + (16 * m + fr) * 272 + 64 * ks + 16 * fq);
                    y = __builtin_amdgcn_mfma_f32_16x16x32_bf16(cf[ks], hf, y, 0, 0, 0);
                }
                const size_t row = trow + 16 * m + fr;
                const u32x2 uu = *(const u32x2*)(Z + row * NZ + 512 + g * 16 + 4 * fq);
                const float s0 = y[0] + dsk[0] * bflo(uu.x), s1 = y[1] + dsk[1] * bfhi(uu.x), s2 = y[2] + dsk[2] * bflo(uu.y), s3 = y[3] + dsk[3] * bfhi(uu.y);
                u32x2 o; o.x = pk2(gelu_tanh(s0), gelu_tanh(s1)); o.y = pk2(gelu_tanh(s2), gelu_tanh(s3));
                *(u32x2*)(GL + row * PW + g * 16 + 4 * fq) = o;
            }
            LDS_WAIT();
        }
    }
    if (PASS == 1) {
        if (hh == 0) { float2* e = EST + (((size_t)b * NCHUNK + c) * 32 + g) * 64 + 2 * n; e[0] = H0; e[1] = H1; }
    } else if (c == NCHUNK - 1) {
        if (hh == 0) {
            float* ore = F.out + O_REP + ((size_t)b * 32 + g) * 64 + 2 * n; float* oim = F.out + O_IMP + ((size_t)b * 32 + g) * 64 + 2 * n;
            ore[0] = H0.x; ore[1] = H1.x; oim[0] = H0.y; oim[1] = H1.y;
        }
    }
}

__device__ __forceinline__ void sample_mixer(const Frame& F) {
    unsigned char* ws = F.ws;
    const bf16_t* Z = (const bf16_t*)(ws + WS_Z);
    bf16_t* POOLED = (bf16_t*)(ws + WS_POOLED); bf16_t* GL = (bf16_t*)(ws + WS_GL);
    const int gt = blockIdx.x * 512 + F.tid, NGT = F.G * 512;
    for (int i = gt; i < MS * PW; i += NGT) {
        const int b = i >> 9, ch = i & 511, grp = ch >> 7, W = 2 << grp;
        const float* st = F.in[4] + (size_t)b * 15 * PW + ch;
        const float u = bflo((unsigned)Z[(size_t)(MPR + b) * NZ + ch]);
        float s = u;
        float* np = F.out + O_POOLS + (size_t)b * 15 * PW + ch;
#pragma unroll
        for (int r = 0; r < 15; ++r) { const float v = st[(size_t)r * PW]; if (r >= 16 - W) s += v; if (r >= 1) np[(size_t)(r - 1) * PW] = v; }
        np[(size_t)14 * PW] = u;
        POOLED[(size_t)(MPR + b) * PW + ch] = (bf16_t)f2bf(s / (float)W - u);
    }
    const float2* ABAR = (const float2*)(ws + WS_ABAR);
    const float* bbfr = (const float*)(ws + WS_BBFR); const float* bbfi = (const float*)(ws + WS_BBFI);
    for (int it = F.gw; it < MS * 32; it += F.NGW) {
        const int b = it >> 5, g = it & 31, p = F.lane;
        const bf16_t* ur = Z + (size_t)(MPR + b) * NZ + 512 + g * 16;
        float u[16];
#pragma unroll
        for (int h = 0; h < 16; ++h) u[h] = bflo((unsigned)ur[h]);
        float br = 0.f, bi = 0.f;
        const f32x4* brp = (const f32x4*)(bbfr + ((size_t)g * 64 + p) * 16); const f32x4* bip = (const f32x4*)(bbfi + ((size_t)g * 64 + p) * 16);
#pragma unroll
        for (int q = 0; q < 4; ++q) { const f32x4 x = brp[q], y = bip[q];
#pragma unroll
            for (int j = 0; j < 4; ++j) { br += x[j] * u[4 * q + j]; bi += y[j] * u[4 * q + j]; } }
        const float2 a = ABAR[g * 64 + p];
        const size_t si = ((size_t)b * 32 + g) * 64 + p;
        const float h0r = F.in[5][si], h0i = F.in[6][si];
        const float hr = a.x * h0r - a.y * h0i + br, hi = a.x * h0i + a.y * h0r + bi;
        F.out[O_RES + si] = hr; F.out[O_IMS + si] = hi;
        float yv = 0.f;
#pragma unroll
        for (int h = 0; h < 16; ++h) {
            const float cr = F.in[16][((size_t)g * 16 + h) * 64 + p], ci = F.in[17][((size_t)g * 16 + h) * 64 + p];
            const float t = wave_sum(cr * hr - ci * hi);
            if (F.lane == h) yv = t + F.in[18][g * 16 + h] * u[h];
        }
        if (F.lane < 16) GL[(size_t)(MPR + b) * PW + g * 16 + F.lane] = (bf16_t)f2bf(gelu_tanh(yv));
    }
}

__global__ void __launch_bounds__(512, 2) fwd_kernel(Args args) {
    extern __shared__ __attribute__((aligned(16))) unsigned char lds_raw[];
    Frame F;
    F.lds = (LAS unsigned char*)lds_raw;
    F.tid = threadIdx.x; F.lane = F.tid & 63; F.wave = __builtin_amdgcn_readfirstlane(F.tid >> 6);
    F.G = gridDim.x; F.gw = blockIdx.x * 8 + F.wave; F.NGW = F.G * 8;
    F.in = args.in; F.out = args.out; F.ws = args.ws;
    unsigned char* ws = args.ws;
    const int lo = args.ph_lo, hi = args.ph_hi;
    volatile LAS unsigned* bst = (volatile LAS unsigned*)(F.lds + 131072 + 1024);
    if (F.tid < 4) bst[F.tid] = 0u;
    __syncthreads();
    XcdBarrier bar; bar.bar = (unsigned*)(ws + WS_BAR); bar.x = 0; bar.st = bst;
    if (args.coop) bar = xcd_barrier_post((unsigned*)(ws + WS_BAR), bst);
    float* SS = (float*)(ws + WS_SS); float* SSP = (float*)(ws + WS_SSP);
    bf16_t* R1 = (bf16_t*)(ws + WS_R1); bf16_t* R2 = (bf16_t*)(ws + WS_R2); bf16_t* Zb = (bf16_t*)(ws + WS_Z);
    bf16_t* POOLED = (bf16_t*)(ws + WS_POOLED); bf16_t* GL = (bf16_t*)(ws + WS_GL); bf16_t* Fb = (bf16_t*)(ws + WS_F);
#define IN(k) (((PHMASK >> (k)) & 1) && lo <= (k) && (k) < hi)
#define SEAM(k) do { if (args.coop && IN(k) && IN((k) + 1)) { if (args.coop == 2) cg::this_grid().sync(); else { xcd_barrier(bar); if (PROBE_BAR) xcd_barrier(bar); } } } while (0)

    if (IN(0)) { p0_prologue(F);
#if PROBE_P0
        p0_prologue(F);
#endif
    }
    SEAM(0);
    if (IN(1)) {
        const bf16_t* W = (const bf16_t*)(ws + WS_WIN);
        pg8::Gemm g{R1, W, MPR, NZ, D, D, D, 0}; pg8::StaticOrder S; S.init(MPR, NZ, F.G, (int)blockIdx.x);
        pg8::EpiStrip<FZ> E{FZ{Zb, SS}};
        pg8::gemm_phase<pg8::EpiStrip<FZ>, true>(F.lds, g, S, E);
        __syncthreads();
        sgemm_phase<FZ, 6, D, NZ>(F, E.f, R1, D, 0, W, D);
#if PROBE_P1
        pg8::gemm_phase<pg8::EpiStrip<FZ>, true>(F.lds, g, S, E);
        __syncthreads();
        sgemm_phase<FZ, 6, D, NZ>(F, E.f, R1, D, 0, W, D);
#endif
    }
    SEAM(1);
    if (IN(2)) {
        for (int rep_ = 0; rep_ < REP_MIX; ++rep_) {
        for (int it = F.gw; it < 4096; it += F.NGW) {
            const int grp = it & 3, tb = it >> 2; const int row0 = tb * 16, t0 = row0 & (SEQ - 1);
            if (grp == 0) pool_item<2>(Zb, POOLED, row0, t0, 0, F.lane);
            else if (grp == 1) pool_item<4>(Zb, POOLED, row0, t0, 1, F.lane);
            else if (grp == 2) pool_item<8>(Zb, POOLED, row0, t0, 2, F.lane);
            else pool_item<16>(Zb, POOLED, row0, t0, 3, F.lane);
        }
        for (int it = F.gw; it < NBATCH * NCHUNK * 32; it += F.NGW) scan_item<1>(F, it, F.lds + F.wave * 16384);
        sample_mixer(F);
        }
        const int gt = blockIdx.x * 512 + F.tid, NGT = F.G * 512;
        for (int i = gt; i < NBATCH * 15 * PW; i += NGT) {
            const int b = i / (15 * PW), r = (i / PW) % 15, ch = i % PW;
            F.out[O_POOLP + i] = bflo((unsigned)Zb[((size_t)b * SEQ + SEQ - 15 + r) * NZ + ch]);
        }
    }
    SEAM(2);
    if (IN(3)) {
        const bf16_t* W = (const bf16_t*)(ws + WS_WPOOL);
        pg8::Gemm g{POOLED, W, MPR, D, 128, PW, 128, 256}; pg8::StaticOrder S; S.init(MPR, D, F.G, (int)blockIdx.x);
        pg8::EpiStrip<FPool> E{FPool{R1, Zb, F.in[10]}};
        pg8::gemm_phase<pg8::EpiStrip<FPool>, true>(F.lds, g, S, E);
#if PROBE_X
        __syncthreads(); pg8::gemm_phase<pg8::EpiStrip<FPool>, true>(F.lds, g, S, E);
#endif
        __syncthreads();
        sgemm_phase<FPool, 2, 128, D>(F, E.f, POOLED, PW, 128, W, 128);
        for (int rep_ = 0; rep_ < REP_MIX; ++rep_)
        for (int it = F.gw; it < NBATCH * NCHUNK * 32; it += F.NGW) scan_item<2>(F, it, F.lds + F.wave * 16384);
    }
    SEAM(3);
    if (IN(4)) {
        const bf16_t* W = (const bf16_t*)(ws + WS_WGLU);
        pg8::Gemm g{GL, W, MPR, 2 * D, PW, PW, PW, 0}; pg8::StaticOrder S; S.init(MPR, 2 * D, F.G, (int)blockIdx.x);
        pg8::EpiStrip<FGlu> E{FGlu{R2, R1, Zb}};
        pg8::gemm_phase<pg8::EpiStrip<FGlu>, true>(F.lds, g, S, E);
#if PROBE_X
        __syncthreads(); pg8::gemm_phase<pg8::EpiStrip<FGlu>, true>(F.lds, g, S, E);
#endif
        __syncthreads();
        sgemm_phase<FGlu, 4, PW, 2 * D>(F, E.f, GL, PW, 0, W, PW);
    }
    SEAM(4);
    if (IN(5)) {
        const bf16_t* W = (const bf16_t*)(ws + WS_WOUT);
        pg8::Gemm g{R2, W, MPR, D, D, D, D, 0}; pg8::StaticOrder S; S.init(MPR, D, F.G, (int)blockIdx.x);
        pg8::EpiStrip<FOut> E{FOut{F.in[0], F.in[1], R1, SSP}};
        pg8::gemm_phase<pg8::EpiStrip<FOut>, true>(F.lds, g, S, E);
        __syncthreads();
        sgemm_phase<FOut, 2, D, D>(F, E.f, R2, D, 0, W, D);
    }
    SEAM(5);
    if (IN(6)) {
        { const bf16_t* W = (const bf16_t*)(ws + WS_WFF1);
          pg8::Gemm g{R1, W, MPR, FF, D, D, D, 0}; pg8::StaticOrder S; S.init(MPR, FF, F.G, (int)blockIdx.x);
          pg8::EpiStrip<FFf1> E{FFf1{Fb, SSP}};
          pg8::gemm_phase<pg8::EpiStrip<FFf1>, true>(F.lds, g, S, E);
          __syncthreads();
          sgemm_phase<FFf1, 8, D, FF>(F, E.f, R1, D, 0, W, D); }
        { const bf16_t* W = (const bf16_t*)(ws + WS_WPLE); const bf16_t* PB = (const bf16_t*)(ws + WS_PB);
          pg8::Gemm g{PB, W, MPR, D, PLE, PLE, PLE, 0}; pg8::StaticOrder S; S.init(MPR, D, F.G, (int)blockIdx.x);
          pg8::EpiStrip<FPle> E{FPle{R2}};
          pg8::gemm_phase<pg8::EpiStrip<FPle>, true>(F.lds, g, S, E);
          __syncthreads();
          sgemm_phase<FPle, 2, PLE, D>(F, E.f, PB, PLE, 0, W, PLE); }
#if PROBE_P6
        { const bf16_t* W = (const bf16_t*)(ws + WS_WFF1);
          pg8::Gemm g{R1, W, MPR, FF, D, D, D, 0}; pg8::StaticOrder S; S.init(MPR, FF, F.G, (int)blockIdx.x);
          pg8::EpiStrip<FFf1> E{FFf1{Fb, SSP}};
          pg8::gemm_phase<pg8::EpiStrip<FFf1>, true>(F.lds, g, S, E);
          __syncthreads();
          sgemm_phase<FFf1, 8, D, FF>(F, E.f, R1, D, 0, W, D); }
        { const bf16_t* W = (const bf16_t*)(ws + WS_WPLE); const bf16_t* PB = (const bf16_t*)(ws + WS_PB);
          pg8::Gemm g{PB, W, MPR, D, PLE, PLE, PLE, 0}; pg8::StaticOrder S; S.init(MPR, D, F.G, (int)blockIdx.x);
          pg8::EpiStrip<FPle> E{FPle{R2}};
          pg8::gemm_phase<pg8::EpiStrip<FPle>, true>(F.lds, g, S, E);
          __syncthreads();
          sgemm_phase<FPle, 2, PLE, D>(F, E.f, PB, PLE, 0, W, PLE); }
#endif
    }
    SEAM(6);
    if (IN(7)) {
        const bf16_t* W = (const bf16_t*)(ws + WS_WFF2);
        pg8::Gemm g{Fb, W, MPR, D, FF, FF, FF, 0}; pg8::StaticOrder S; S.init(MPR, D, F.G, (int)blockIdx.x);
        pg8::EpiStrip<FFf2> E{FFf2{R1, SSP + SSP_STRIDE}};
        pg8::gemm_phase<pg8::EpiStrip<FFf2>, true>(F.lds, g, S, E);
        __syncthreads();
        sgemm_phase<FFf2, 2, FF, D>(F, E.f, Fb, FF, 0, W, FF);
    }
    SEAM(7);
    if (IN(8)) {
        const bf16_t* W = (const bf16_t*)(ws + WS_WPLEG);
        pg8::Gemm g{R1, W, MPR, D, D, D, D, 0}; pg8::StaticOrder S; S.init(MPR, D, F.G, (int)blockIdx.x);
        pg8::EpiStrip<FPleg> E{FPleg{R1, Zb, R2, SSP + SSP_STRIDE, SSP + 2 * SSP_STRIDE}};
        pg8::gemm_phase<pg8::EpiStrip<FPleg>, true>(F.lds, g, S, E);
        __syncthreads();
        sgemm_phase<FPleg, 2, D, D>(F, E.f, R1, D, 0, W, D);
    }
    SEAM(8);
    if (IN(9)) {
        const float* ss3 = SSP + 2 * SSP_STRIDE; const f32x4* gf = (const f32x4*)F.in[28];
        for (int m0 = F.gw; m0 < MV; m0 += 2 * F.NGW) {
            u32x4 v[2][2];
#pragma unroll
            for (int q = 0; q < 2; ++q) { const int m = m0 + q * F.NGW;
                if (m < MV) { const u32x4* xr = (const u32x4*)(Zb + (size_t)m * D) + F.lane; v[q][0] = xr[0]; v[q][1] = xr[64]; } }
#pragma unroll
            for (int q = 0; q < 2; ++q) { const int m = m0 + q * F.NGW;
                if (m < MV) { const float rs = ssp_rstd(ss3, m); f32x4* yr = (f32x4*)(F.out + (size_t)m * D);
#pragma unroll
                    for (int j = 0; j < 2; ++j) { const int c4 = (64 * j + F.lane) * 2;
                        const u32x4 w = v[q][j];
                        f32x4 a = (f32x4){bflo(w.x), bfhi(w.x), bflo(w.y), bfhi(w.y)}, b = (f32x4){bflo(w.z), bfhi(w.z), bflo(w.w), bfhi(w.w)};
                        a = a * rs; b = b * rs; a = a * gf[c4]; b = b * gf[c4 + 1]; yr[c4] = a; yr[c4 + 1] = b; } } }
        }
    }
#undef IN
#undef SEAM
}

extern "C" void kernel_launch(void* const* d_in, const int* in_sizes, int n_in, void* d_out, int out_size, void* d_ws, size_t ws_size, hipStream_t stream) {
    static int grid = 0;
    if (grid == 0) {
        int dev = 0, cus = 0, per_cu = 0;
        hipGetDevice(&dev);
        hipDeviceGetAttribute(&cus, hipDeviceAttributeMultiprocessorCount, dev);
        hipFuncSetAttribute((const void*)fwd_kernel, hipFuncAttributeMaxDynamicSharedMemorySize, LDS_BYTES);
        hipOccupancyMaxActiveBlocksPerMultiprocessor(&per_cu, (const void*)fwd_kernel, 512, LDS_BYTES);
        (void)hipGetLastError();
        if (per_cu < 1) per_cu = 1;
        grid = cus * 1;
        if (grid <= 0) grid = 256;
        if (ws_size < WS_END) { fprintf(stderr, "workspace too small: %zu < %zu\n", ws_size, (size_t)WS_END); }
    }
    Args a{};
    for (int i = 0; i < 29; ++i) a.in[i] = (const float*)d_in[i];
    a.out = (float*)d_out; a.ws = (unsigned char*)d_ws;
#if ONE_LAUNCH
    a.ph_lo = 0; a.ph_hi = 10; a.coop = 1;
    hipMemsetAsync((unsigned char*)d_ws + WS_BAR, 0, BAR_BYTES, stream);
    void* kargs[] = {&a};
    hipError_t e = hipLaunchCooperativeKernel((const void*)fwd_kernel, dim3(grid), dim3(512), kargs, LDS_BYTES, stream);
    if (e != hipSuccess) fprintf(stderr, "cooperative launch failed: %s (grid %d)\n", hipGetErrorString(e), grid);
#else
    for (int ph = 0; ph < 10; ++ph) {
        a.ph_lo = ph; a.ph_hi = ph + 1; a.coop = 0;
        hipLaunchKernelGGL(fwd_kernel, dim3(grid), dim3(512), LDS_BYTES, stream, a);
    }
#endif
}
```
